# Optimizing an MI355X kernel written in HIP

```python
import math
import jax, jax.numpy as jnp
from jax import lax
import numpy as np


D_MODEL = 2048
BATCH = 1
SEQ = 8192
DEPTH = 2

CHUNK = 64
Q_BLOCK = 128
N_MIXERS = 2
N_ATTN_LAYERS = (DEPTH + 1) // 2
N_GDN_LAYERS = DEPTH // 2
RMS_EPS = 1e-6

DIFF_HEADS = D_MODEL // 256
DIFF_HEAD_DIM = 128
DIFF_QK_DIM = 2 * DIFF_HEADS * DIFF_HEAD_DIM
DIFF_V_DIM = DIFF_HEADS * 2 * DIFF_HEAD_DIM
LAMBDA_STD = 0.1

GDN_HEAD_DIM = 128
GDN_QK_HEADS = D_MODEL // 128
GDN_V_HEADS = 2 * GDN_QK_HEADS
GDN_REPEAT = GDN_V_HEADS // GDN_QK_HEADS
GDN_KEY_DIM = GDN_QK_HEADS * GDN_HEAD_DIM
GDN_VALUE_DIM = GDN_V_HEADS * GDN_HEAD_DIM
GDN_CONV = 4
GDN_IN_DIM = 2 * GDN_KEY_DIM + 2 * GDN_VALUE_DIM + 2 * GDN_V_HEADS

D_FF = ((8 * D_MODEL // 3 + 127) // 128) * 128
FFN_CONV = 3

kernel_name = 'hybrid_diffattn_gdn_convffn'


def rms_norm(x, g):
    xf = x.astype(jnp.float32)
    y = xf * lax.rsqrt(jnp.mean(xf * xf, axis=-1, keepdims=True) + RMS_EPS)
    return (y * g.astype(jnp.float32)).astype(x.dtype)


def l2_norm(x):
    return x * lax.rsqrt(jnp.sum(x * x, axis=-1, keepdims=True) + RMS_EPS)


def causal_dwconv(u, w):
    k_width = w.shape[0]
    s = u.shape[1]
    up = jnp.pad(u, ((0, 0), (k_width - 1, 0), (0, 0)))
    out = up[:, 0:s] * w[0]
    for j in range(1, k_width):
        out = out + up[:, j:j + s] * w[j]
    return out


def alibi_slopes(n_heads):
    return jnp.exp2(-8.0 * jnp.arange(1, n_heads + 1, dtype=jnp.float32) / n_heads)


def diff_attention(h, w_qkv, q_norm, k_norm, lq1, lk1, lq2, lk2, subln, w_o, lambda_init):
    b_sz, s_len, _ = h.shape
    n_blocks = s_len // Q_BLOCK
    qkv = h @ w_qkv
    q, k, v = jnp.split(qkv, [DIFF_QK_DIM, 2 * DIFF_QK_DIM], axis=-1)
    q = rms_norm(q.reshape(b_sz, s_len, 2 * DIFF_HEADS, DIFF_HEAD_DIM), q_norm) * (DIFF_HEAD_DIM ** -0.5)
    k = rms_norm(k.reshape(b_sz, s_len, 2 * DIFF_HEADS, DIFF_HEAD_DIM), k_norm)
    v = v.reshape(b_sz, s_len, DIFF_HEADS, 2 * DIFF_HEAD_DIM)
    lam = (jnp.exp(jnp.sum(lq1.astype(jnp.float32) * lk1.astype(jnp.float32)))
           - jnp.exp(jnp.sum(lq2.astype(jnp.float32) * lk2.astype(jnp.float32))) + lambda_init)
    q_blocks = q.reshape(b_sz, n_blocks, Q_BLOCK, 2 * DIFF_HEADS, DIFF_HEAD_DIM).transpose(1, 0, 3, 2, 4)
    k_t = k.transpose(0, 2, 1, 3)
    v_t = v.transpose(0, 2, 1, 3)
    k_pos = jnp.arange(s_len, dtype=jnp.int32)
    k_chunk = k_pos // CHUNK
    slopes = jnp.repeat(alibi_slopes(DIFF_HEADS), 2)

    def block(args):
        q_blk, blk = args
        q_pos = blk * Q_BLOCK + jnp.arange(Q_BLOCK, dtype=jnp.int32)
        s = jnp.einsum('bhqd,bhkd->bhqk', q_blk, k_t).astype(jnp.float32)
        dist = jnp.abs(q_pos[:, None] - k_pos[None, :]).astype(jnp.float32)
        s = s - slopes[:, None, None] * dist
        allowed = k_chunk[None, :] <= (q_pos // CHUNK)[:, None]
        s = jnp.where(allowed, s, -jnp.inf)
        p = jax.nn.softmax(s, axis=-1).reshape(b_sz, DIFF_HEADS, 2, Q_BLOCK, s_len)
        a = p[:, :, 0] - lam * p[:, :, 1]
        return jnp.einsum('bhqk,bhke->bhqe', a.astype(v_t.dtype), v_t)

    o = lax.map(block, (q_blocks, jnp.arange(n_blocks, dtype=jnp.int32)))
    o = o.transpose(1, 0, 3, 2, 4).reshape(b_sz, s_len, DIFF_HEADS, 2 * DIFF_HEAD_DIM)
    o = rms_norm(o, subln) * (1.0 - lambda_init)
    return o.reshape(b_sz, s_len, DIFF_V_DIM) @ w_o


def gated_delta_rule(q, k, v, g, beta):
    b_sz, s_len, n_h, dk = q.shape
    dv = v.shape[-1]
    n_c = s_len // CHUNK
    q = q * (dk ** -0.5)

    def to_chunks(t):
        return t.reshape(b_sz, n_c, CHUNK, n_h, -1).transpose(0, 3, 1, 2, 4)

    q, k, v = to_chunks(q), to_chunks(k), to_chunks(v)
    beta_c = beta.reshape(b_sz, n_c, CHUNK, n_h).transpose(0, 3, 1, 2)
    g_c = jnp.cumsum(g.reshape(b_sz, n_c, CHUNK, n_h).transpose(0, 3, 1, 2), axis=-1)
    k_beta = k * beta_c[..., None]
    v_beta = v * beta_c[..., None]
    tril = jnp.tril(jnp.ones((CHUNK, CHUNK), dtype=bool))
    strict = jnp.tril(jnp.ones((CHUNK, CHUNK), dtype=bool), -1)
    decay = jnp.exp(jnp.where(tril, g_c[..., :, None] - g_c[..., None, :], -jnp.inf))
    low = jnp.where(strict, jnp.einsum('bhncd,bhnkd->bhnck', k_beta, k) * decay, 0.0)
    a_mat = low + jnp.eye(CHUNK, dtype=low.dtype)
    u = lax.linalg.triangular_solve(a_mat, v_beta, left_side=True, lower=True, unit_diagonal=True)
    w = lax.linalg.triangular_solve(a_mat, k_beta * jnp.exp(g_c)[..., None], left_side=True, lower=True, unit_diagonal=True)
    qk = jnp.where(tril, jnp.einsum('bhncd,bhnkd->bhnck', q, k) * decay, 0.0)
    q_dec = q * jnp.exp(g_c)[..., None]
    k_dec = k * jnp.exp(g_c[..., -1:] - g_c)[..., None]
    g_last = jnp.exp(g_c[..., -1])

    def step(state, xs):
        qk_n, u_n, w_n, qd_n, kd_n, gl_n = xs
        v_new = u_n - jnp.einsum('bhcd,bhde->bhce', w_n, state)
        o = jnp.einsum('bhcd,bhde->bhce', qd_n, state) + jnp.einsum('bhck,bhke->bhce', qk_n, v_new)
        state = state * gl_n[..., None, None] + jnp.einsum('bhcd,bhce->bhde', kd_n, v_new)
        return state, o

    xs = tuple(t.transpose(2, 0, 1, 3, 4) for t in (qk, u, w, q_dec, k_dec)) + (g_last.transpose(2, 0, 1),)
    state0 = jnp.zeros((b_sz, n_h, dk, dv), dtype=jnp.float32)
    _, o = lax.scan(step, state0, xs)
    return o.transpose(1, 0, 3, 2, 4).reshape(b_sz, s_len, n_h, dv)


def gated_deltanet(h, w_in, conv_w, a_log, dt_bias, norm_g, w_out):
    b_sz, s_len, _ = h.shape
    proj = h @ w_in
    qkv, z, b_gate, a_gate = jnp.split(
        proj, [2 * GDN_KEY_DIM + GDN_VALUE_DIM, 2 * GDN_KEY_DIM + 2 * GDN_VALUE_DIM,
               2 * GDN_KEY_DIM + 2 * GDN_VALUE_DIM + GDN_V_HEADS], axis=-1)
    qkv = jax.nn.silu(causal_dwconv(qkv, conv_w))
    q, k, v = jnp.split(qkv, [GDN_KEY_DIM, 2 * GDN_KEY_DIM], axis=-1)
    q = l2_norm(q.reshape(b_sz, s_len, GDN_QK_HEADS, GDN_HEAD_DIM).astype(jnp.float32))
    k = l2_norm(k.reshape(b_sz, s_len, GDN_QK_HEADS, GDN_HEAD_DIM).astype(jnp.float32))
    q = jnp.repeat(q, GDN_REPEAT, axis=2)
    k = jnp.repeat(k, GDN_REPEAT, axis=2)
    v = v.reshape(b_sz, s_len, GDN_V_HEADS, GDN_HEAD_DIM).astype(jnp.float32)
    beta = jax.nn.sigmoid(b_gate.astype(jnp.float32))
    g = -jnp.exp(a_log.astype(jnp.float32)) * jax.nn.softplus(a_gate.astype(jnp.float32) + dt_bias.astype(jnp.float32))
    o = gated_delta_rule(q, k, v, g, beta)
    o = rms_norm(o, norm_g) * jax.nn.silu(z.reshape(b_sz, s_len, GDN_V_HEADS, GDN_HEAD_DIM).astype(jnp.float32))
    return o.reshape(b_sz, s_len, GDN_VALUE_DIM).astype(h.dtype) @ w_out


def conv_ffn(h, w_up, conv_w, conv_b, w_down):
    u = causal_dwconv(h @ w_up, conv_w) + conv_b
    val, gate = jnp.split(u, 2, axis=-1)
    return (jax.nn.silu(gate) * val) @ w_down


def setup_inputs(seed: int = 0) -> dict:
    key = jax.random.key(seed)
    ks = jax.random.split(key, 24)
    f32 = jnp.float32

    def nrm(k, shape, scale):
        return jax.random.normal(k, shape, dtype=f32) * scale

    def gain(k, shape):
        return 1.0 + 0.02 * jax.random.normal(k, shape, dtype=f32)

    na, nb = N_ATTN_LAYERS, N_GDN_LAYERS
    dt = jnp.exp(jax.random.uniform(ks[16], (nb, GDN_V_HEADS), dtype=f32,
                                    minval=math.log(0.001), maxval=math.log(0.1)))
    return {
        'x': nrm(ks[0], (BATCH, SEQ, D_MODEL), 1.0),
        'mixer_norm': gain(ks[1], (DEPTH, D_MODEL)),
        'ffn_norm': gain(ks[2], (DEPTH, D_MODEL)),
        'diff_w_qkv': nrm(ks[3], (na, D_MODEL, 2 * DIFF_QK_DIM + DIFF_V_DIM), D_MODEL ** -0.5),
        'diff_q_norm': gain(ks[4], (na, DIFF_HEAD_DIM)),
        'diff_k_norm': gain(ks[5], (na, DIFF_HEAD_DIM)),
        'diff_lambda_q1': nrm(ks[6], (na, DIFF_HEAD_DIM), LAMBDA_STD),
        'diff_lambda_k1': nrm(ks[7], (na, DIFF_HEAD_DIM), LAMBDA_STD),
        'diff_lambda_q2': nrm(ks[8], (na, DIFF_HEAD_DIM), LAMBDA_STD),
        'diff_lambda_k2': nrm(ks[9], (na, DIFF_HEAD_DIM), LAMBDA_STD),
        'diff_subln': gain(ks[10], (na, 2 * DIFF_HEAD_DIM)),
        'diff_w_o': nrm(ks[11], (na, DIFF_V_DIM, D_MODEL), DIFF_V_DIM ** -0.5),
        'gdn_w_in': nrm(ks[12], (nb, D_MODEL, GDN_IN_DIM), D_MODEL ** -0.5),
        'gdn_conv_w': nrm(ks[13], (nb, GDN_CONV, 2 * GDN_KEY_DIM + GDN_VALUE_DIM), GDN_CONV ** -0.5),
        'gdn_A_log': jnp.log(jax.random.uniform(ks[14], (nb, GDN_V_HEADS), dtype=f32, minval=1.0, maxval=16.0)),
        'gdn_dt_bias': dt + jnp.log(-jnp.expm1(-dt)),
        'gdn_norm': gain(ks[15], (nb, GDN_HEAD_DIM)),
        'gdn_w_out': nrm(ks[17], (nb, GDN_VALUE_DIM, D_MODEL), GDN_VALUE_DIM ** -0.5),
        'ffn_w_up': nrm(ks[18], (DEPTH, D_MODEL, 2 * D_FF), D_MODEL ** -0.5),
        'ffn_conv_w': nrm(ks[19], (DEPTH, FFN_CONV, 2 * D_FF), FFN_CONV ** -0.5),
        'ffn_conv_b': nrm(ks[20], (DEPTH, 2 * D_FF), 0.02),
        'ffn_w_down': nrm(ks[21], (DEPTH, D_FF, D_MODEL), D_FF ** -0.5),
    }


def reference(x, mixer_norm, ffn_norm, diff_w_qkv, diff_q_norm, diff_k_norm, diff_lambda_q1,
              diff_lambda_k1, diff_lambda_q2, diff_lambda_k2, diff_subln, diff_w_o, gdn_w_in,
              gdn_conv_w, gdn_A_log, gdn_dt_bias, gdn_norm, gdn_w_out, ffn_w_up, ffn_conv_w,
              ffn_conv_b, ffn_w_down):
    for i in range(DEPTH):
        h = rms_norm(x, mixer_norm[i])
        j = i // N_MIXERS
        if i % N_MIXERS == 0:
            lambda_init = 0.8 - 0.6 * math.exp(-0.3 * i)
            x = x + diff_attention(h, diff_w_qkv[j], diff_q_norm[j], diff_k_norm[j], diff_lambda_q1[j],
                                   diff_lambda_k1[j], diff_lambda_q2[j], diff_lambda_k2[j],
                                   diff_subln[j], diff_w_o[j], lambda_init)
        else:
            x = x + gated_deltanet(h, gdn_w_in[j], gdn_conv_w[j], gdn_A_log[j], gdn_dt_bias[j],
                                   gdn_norm[j], gdn_w_out[j])
        x = x + conv_ffn(rms_norm(x, ffn_norm[i]), ffn_w_up[i], ffn_conv_w[i], ffn_conv_b[i], ffn_w_down[i])
    return x
```

```cpp
#include <hip/hip_runtime.h>
#include <hip/hip_bf16.h>
#include <hip/hip_cooperative_groups.h>
#include <cstdio>
#include <cstdint>
namespace cg = cooperative_groups;
__device__ __forceinline__ int otid() { int t = (int)__builtin_amdgcn_workitem_id_x(); asm volatile("" : "+v"(t)); return t; }
#include <hip/hip_runtime.h>
namespace pg8 {
#define PG8_LAS __attribute__((address_space(3)))
typedef unsigned short bf16_t;
typedef short bf16x8 __attribute__((ext_vector_type(8)));
typedef float f32x4 __attribute__((ext_vector_type(4)));
typedef unsigned u32x4 __attribute__((ext_vector_type(4)));
constexpr int BM = 256, BK = 64, HALF = 128, HTB = HALF * BK * 2  , STAGE_BYTES = 8 * HTB, NXCD = 8, WGM = 8;

__host__ __device__ __forceinline__ int lds_byte(int r, int c) { const int st = (r >> 4) * 2 + (c >> 5), rr = r & 15, cc = c & 31, ob = rr * 64 + cc * 2; return st * 1024 + (ob ^ (((ob >> 9) & 1) << 5)); }
__host__ __device__ __forceinline__ void stage_rc(int b, int& R, int& C) { const int st = b / 1024, sb = b % 1024, swz = sb ^ (((sb >> 9) & 1) << 5); R = (st >> 1) * 16 + swz / 64; C = (st & 1) * 32 + (swz % 64) / 2; }
__host__ __device__ __forceinline__ int perm32(int rho) { const int n = rho >> 4, i = rho & 15; return 8 * (i >> 2) + 4 * n + (i & 3); }

struct Unit { int pm, pn; };
struct Gemm { const bf16_t* A; const bf16_t* Bt; int M, N, K; };

struct StaticOrder {
    int nM, nN, nwg, G, c;
    __host__ __device__ void init(int M, int N, int G_, int c_) { nM = M / BM; nN = N / BM; nwg = nM * nN; G = G_; c = c_; }
    __host__ __device__ bool next(int i, Unit& u) const {
        const long L = (long)i * G + c; if (L >= nwg) return false;
        int wgid = (int)L; { const int q = nwg / NXCD, r = nwg % NXCD, xcd = wgid % NXCD, off = wgid / NXCD; wgid = (xcd < r ? xcd * (q + 1) : r * (q + 1) + (xcd - r) * q) + off; }
        const int nig = WGM * nN, gid = wgid / nig, fm = gid * WGM, gsz = (nM - fm) < WGM ? (nM - fm) : WGM;
        u.pm = fm + ((wgid % nig) % gsz); u.pn = (wgid % nig) / gsz; return true;
    }
    __device__ __forceinline__ void a_ready(const Unit&) const {}
    __device__ __forceinline__ void done(const Unit&) const {}
};
struct CountedOrder : StaticOrder {
    const unsigned* ready; unsigned need; unsigned* tmo;
    __device__ __forceinline__ void a_ready(const Unit& u) const {
        if (otid() < 64) {
            const unsigned long long t0 = __builtin_amdgcn_s_memrealtime(); unsigned polls = 0;
            while ((unsigned)__builtin_amdgcn_readfirstlane(__hip_atomic_load(ready + 64 * u.pm, __ATOMIC_RELAXED, __HIP_MEMORY_SCOPE_AGENT)) < need) {
                if ((++polls & 255u) == 0u && __builtin_amdgcn_readfirstlane(__hip_atomic_load(tmo, __ATOMIC_RELAXED, __HIP_MEMORY_SCOPE_AGENT)) != 0u) break;
                if (__builtin_amdgcn_s_memrealtime() - t0 > 2000000ull) {
                    if (otid() == 0) { unsigned expect = 0u; __hip_atomic_compare_exchange_strong(tmo + 1, &expect, 0x600u | (unsigned)(u.pm & 0xff), __ATOMIC_RELAXED, __ATOMIC_RELAXED, __HIP_MEMORY_SCOPE_AGENT); __hip_atomic_store(tmo, 1u, __ATOMIC_RELAXED, __HIP_MEMORY_SCOPE_AGENT); }
                    break; }
                __builtin_amdgcn_s_sleep(2); }
            __builtin_amdgcn_fence(__ATOMIC_ACQUIRE, "agent");
            asm volatile("s_waitcnt vmcnt(0)" ::: "memory");
        }
#if !defined(BROKEN_HOOK_NO_BARRIER)
        asm volatile("" ::: "memory"); __builtin_amdgcn_s_barrier(); asm volatile("" ::: "memory");
#endif
    }
};

template <class Epi, class Sched, bool STAMP = false>
__device__ __forceinline__ void gemm_phase(PG8_LAS unsigned char* lds, const Gemm g, const Sched& S, const Epi& E, unsigned long long* stamps) {
    const int tid = otid(), wid = __builtin_amdgcn_readfirstlane(tid >> 6), lane = tid & 63, wr = wid >> 2, wc = wid & 3, fr = lane & 15, fq = lane >> 4;
    const int K = g.K, nt = K / BK;
    int ts_lo = 0, ts_hi = 0, nts = 0; const unsigned long long rt_entry = STAMP ? (unsigned long long)wall_clock64() : 0ull;
#define PG8_STAMP() do { if (STAMP && wid == 0 && nts < 64) { const unsigned long long _c = (unsigned long long)clock64(); \
        ts_lo = (lane == nts) ? (int)(unsigned)_c : ts_lo; ts_hi = (lane == nts) ? (int)(unsigned)(_c >> 32) : ts_hi; ++nts; } } while (0)
    PG8_STAMP();
    unsigned voffA[2], voffB[2];
#pragma unroll
    for (int i = 0; i < 2; ++i) { int R, C; stage_rc(tid * 16 + i * 8192, R, C); const int Rb = Epi::PERM ? ((R & ~31) + perm32(R & 31)) : R;
        voffA[i] = (unsigned)(R * K + C) * 2u; voffB[i] = (unsigned)(Rb * K + C) * 2u; }
    const size_t kstep = (size_t)(BK * 2);
    const size_t hstep = (size_t)HALF * K * 2;
    const size_t tstep = 2 * hstep;
    const unsigned ldsw = (unsigned)wid * 1024u;
    const int aoff = lds_byte(wr * 64 + fr, fq * 8), boff = lds_byte(wc * 32 + fr, fq * 8);
#define PG8_SA(b, h) (((b) * 2 + (h)) * HTB)
#define PG8_SB(b, h) ((4 + (b) * 2 + (h)) * HTB)
#define PG8_STAGE(bufoff, gbase, voff) do { _Pragma("unroll") for (int _i = 0; _i < 2; ++_i) \
        __builtin_amdgcn_global_load_lds((const unsigned*)((const char*)(gbase) + (voff)[_i]), (PG8_LAS unsigned*)(lds + (bufoff) + ldsw + _i * 8192), 16, 0, 0); } while (0)
#define PG8_LDA(dst, b, h) do { _Pragma("unroll") for (int m = 0; m < 4; ++m) _Pragma("unroll") for (int k = 0; k < 2; ++k) dst[m][k] = *(const PG8_LAS bf16x8*)(lds + PG8_SA(b, h) + aoff + m * 2048 + k * 1024); } while (0)
#define PG8_LDB(dst, b, h) do { _Pragma("unroll") for (int n = 0; n < 2; ++n) _Pragma("unroll") for (int k = 0; k < 2; ++k) dst[n][k] = *(const PG8_LAS bf16x8*)(lds + PG8_SB(b, h) + boff + n * 2048 + k * 1024); } while (0)
#define PG8_MMA(ai, bj, At, Bt) do { __builtin_amdgcn_s_setprio(1); _Pragma("unroll") for (int m = 0; m < 4; ++m) _Pragma("unroll") for (int n = 0; n < 2; ++n) _Pragma("unroll") for (int k = 0; k < 2; ++k) \
        acc[ai][bj][m][n] = __builtin_amdgcn_mfma_f32_16x16x32_bf16(Bt[n][k], At[m][k], acc[ai][bj][m][n], 0, 0, 0); __builtin_amdgcn_s_setprio(0); } while (0)
#define PG8_WAIT_V(n) asm volatile("s_waitcnt vmcnt(" #n ")" ::: "memory")
#define PG8_WAIT_L(n) asm volatile("s_waitcnt lgkmcnt(" #n ")" ::: "memory")
#define PG8_BAR __builtin_amdgcn_s_barrier()
#define PG8_SCHED __builtin_amdgcn_sched_barrier(0)
    Unit cur, nxt; int ui = 0;
    if (!S.next(0, cur)) return;
    f32x4 acc[2][2][4][2];
#pragma unroll
    for (int a = 0; a < 2; ++a)
#pragma unroll
        for (int b = 0; b < 2; ++b)
#pragma unroll
            for (int m = 0; m < 4; ++m)
#pragma unroll
                for (int n = 0; n < 2; ++n) acc[a][b][m][n] = (f32x4){0.f, 0.f, 0.f, 0.f};
    bf16x8 At[4][2], B0[2][2], B1[2][2];
    const char* cA = (const char*)g.A + (size_t)cur.pm * tstep; const char* cB = (const char*)g.Bt + (size_t)cur.pn * tstep;
    S.a_ready(cur);
    PG8_STAGE(PG8_SB(0, 0), cB, voffB); PG8_STAGE(PG8_SA(0, 0), cA, voffA); PG8_STAGE(PG8_SB(0, 1), cB + hstep, voffB); PG8_STAGE(PG8_SA(0, 1), cA + hstep, voffA);
    if (wr == 1) PG8_BAR;
    PG8_WAIT_V(4); PG8_BAR;
    PG8_STAGE(PG8_SB(1, 0), cB + kstep, voffB); PG8_STAGE(PG8_SA(1, 0), cA + kstep, voffA); PG8_STAGE(PG8_SB(1, 1), cB + hstep + kstep, voffB);
    PG8_WAIT_V(6); PG8_BAR;
    PG8_STAMP();
    for (;;) {
        const bool has_next = S.next(ui + 1, nxt);
        const char* nA = has_next ? (const char*)g.A + (size_t)nxt.pm * tstep : cA; const char* nB = has_next ? (const char*)g.Bt + (size_t)nxt.pn * tstep : cB;
        for (int t = 0; t < nt; t += 2) {
            const bool last = (t == nt - 2);
            const char* a1 = cA + (size_t)(t + 1) * kstep;
            const char* a2 = last ? nA : cA + (size_t)(t + 2) * kstep; const char* b2 = last ? nB : cB + (size_t)(t + 2) * kstep;
            const char* a3 = a2 + kstep; const char* b3 = b2 + kstep;
            if (last && has_next) S.a_ready(nxt);
            PG8_LDB(B0, 0, 0); PG8_SCHED; PG8_LDA(At, 0, 0); PG8_STAGE(PG8_SA(1, 1), a1 + hstep, voffA);
            PG8_WAIT_L(8); PG8_BAR; PG8_WAIT_L(0); PG8_MMA(0, 0, At, B0); PG8_BAR; PG8_SCHED;
            PG8_LDB(B1, 0, 1); PG8_STAGE(PG8_SB(0, 0), b2, voffB);
            PG8_BAR; PG8_WAIT_L(0); PG8_MMA(0, 1, At, B1); PG8_BAR;
            PG8_LDA(At, 0, 1); PG8_STAGE(PG8_SA(0, 0), a2, voffA);
            PG8_BAR; PG8_WAIT_L(0); PG8_MMA(1, 0, At, B0); PG8_BAR; PG8_SCHED;
            PG8_STAGE(PG8_SB(0, 1), b2 + hstep, voffB);
            PG8_WAIT_V(6); PG8_BAR; PG8_MMA(1, 1, At, B1); PG8_BAR;
            PG8_LDB(B0, 1, 0); PG8_SCHED; PG8_LDA(At, 1, 0); PG8_STAGE(PG8_SA(0, 1), a2 + hstep, voffA);
            PG8_WAIT_L(8); PG8_BAR; PG8_WAIT_L(0); PG8_MMA(0, 0, At, B0); PG8_BAR; PG8_SCHED;
            PG8_LDB(B1, 1, 1); PG8_STAGE(PG8_SB(1, 0), b3, voffB);
            PG8_BAR; PG8_WAIT_L(0); PG8_MMA(0, 1, At, B1); PG8_BAR;
            PG8_LDA(At, 1, 1); PG8_STAGE(PG8_SA(1, 0), a3, voffA);
            PG8_BAR; PG8_WAIT_L(0); PG8_MMA(1, 0, At, B0); PG8_BAR; PG8_SCHED;
            PG8_STAGE(PG8_SB(1, 1), b3 + hstep, voffB);
            PG8_WAIT_V(6); PG8_BAR; PG8_MMA(1, 1, At, B1); PG8_BAR;
        }
        PG8_STAMP();
        if constexpr (!Epi::AFTER_DRAIN) { E(acc, cur, wr, wc, fr, fq); S.done(cur); }
        PG8_STAMP();
        if (!has_next) break;
#pragma unroll
        for (int a = 0; a < 2; ++a)
#pragma unroll
            for (int b = 0; b < 2; ++b)
#pragma unroll
                for (int m = 0; m < 4; ++m)
#pragma unroll
                    for (int n = 0; n < 2; ++n) acc[a][b][m][n] = (f32x4){0.f, 0.f, 0.f, 0.f};
        cur = nxt; cA = nA; cB = nB; ++ui;
    }
    PG8_WAIT_V(0);
    if (wr == 0) PG8_BAR;
    PG8_BAR;
    if constexpr (Epi::AFTER_DRAIN) { E.fused(acc, cur, wr, wc, fr, fq, lds, wid, lane); S.done(cur); }
    PG8_STAMP();
    if (STAMP && wid == 0) { stamps[lane] = lane < nts ? (((unsigned long long)(unsigned)ts_hi << 32) | (unsigned)ts_lo) : 0ull;
        if (lane == 62) stamps[62] = rt_entry; if (lane == 63) stamps[63] = (unsigned long long)wall_clock64(); }
#undef PG8_STAMP
#undef PG8_SA
#undef PG8_SB
#undef PG8_STAGE
#undef PG8_LDA
#undef PG8_LDB
#undef PG8_MMA
#undef PG8_WAIT_V
#undef PG8_WAIT_L
#undef PG8_BAR
#undef PG8_SCHED
}
}
namespace att {
constexpr int D = 128;
constexpr float SCALE = 0.08838834764831845f;
constexpr int NW = 8, QBLK = 32, KVBLK = 64, QB = NW * QBLK;
constexpr int SHM_V = KVBLK * D * 2, SHM_K = KVBLK * D * 2;
constexpr int LDS_BYTES = 2 * SHM_V + 2 * SHM_K + NW * 64 * 4;
constexpr float THR = 8.f; constexpr bool WSKIP = false;

using bf16 = __hip_bfloat16;
typedef short bf16x8 __attribute__((ext_vector_type(8)));
typedef short s16x4 __attribute__((ext_vector_type(4)));
typedef float f32x16 __attribute__((ext_vector_type(16)));
typedef float f32x4 __attribute__((ext_vector_type(4)));
typedef unsigned u32x4 __attribute__((ext_vector_type(4)));
template <class A, class Bt> struct same_t { static constexpr bool v = false; };
template <class A> struct same_t<A, A> { static constexpr bool v = true; };

#define KSWZ(row, colB) ((row) * 256 + ((colB) ^ (((row) & 7) << 4)))
#define SBAR() __builtin_amdgcn_sched_barrier(0)
__device__ __forceinline__ int v_st(int k, int c) { const int kk = (k & ~0xC) | ((k & 4) << 1) | ((k & 8) >> 1); return ((kk >> 3) * 4 + (c >> 5)) * 512 + ((kk & 7) * 32 + (c & 31)) * 2; }
__device__ __forceinline__ int v_rd_base(int lane) { return ((lane & 3) << 3) | (((lane >> 2) & 3) << 6) | (((lane >> 4) & 1) << 5) | (((lane >> 5) & 1) << 8); }
constexpr int v_rd_off(int d0, int ks, int half) { return d0 * 512 + ks * 4096 + half * 2048; }
__device__ __forceinline__ int crow(int r, int hi) { return (r & 3) + 8 * (r >> 2) + 4 * hi; }
__device__ __forceinline__ unsigned cvtpk(float lo, float hi) {
    unsigned r; asm volatile("v_cvt_pk_bf16_f32 %0, %1, %2" : "=v"(r) : "v"(lo), "v"(hi)); return r;
}
__device__ __forceinline__ bf16x8 pack8(f32x4 a, f32x4 b) {
    u32x4 w = {cvtpk(a[0], a[1]), cvtpk(a[2], a[3]), cvtpk(b[0], b[1]), cvtpk(b[2], b[3])};
    return *reinterpret_cast<bf16x8*>(&w);
}
template <class T> __device__ __forceinline__ bf16x8 load8(const T* p) {
    if constexpr (same_t<T, float>::v) { return pack8(*(const f32x4*)p, *(const f32x4*)(p + 4)); }
    else { return *reinterpret_cast<const bf16x8*>(p); }
}
__device__ __forceinline__ void mask_tile(f32x16& p0, f32x16& p1, int dq, unsigned W) {
    const float NEG = -__builtin_inff();
#pragma unroll
    for (int r = 0; r < 16; ++r) {
        const int c = (r & 3) + 8 * (r >> 2);
        if ((unsigned)(dq - c) >= W) p0[r] = NEG;
        if ((unsigned)(dq - c - 32) >= W) p1[r] = NEG;
    }
}
__device__ __forceinline__ void partialSM(f32x16& p0, f32x16& p1, float& m_reg, float& mn, float& alpha) {
    float pmax = p0[0]; for (int r = 1; r < 16; ++r) pmax = fmaxf(pmax, p0[r]); for (int r = 0; r < 16; ++r) pmax = fmaxf(pmax, p1[r]);
    { auto rr = __builtin_amdgcn_permlane32_swap(__float_as_uint(pmax), __float_as_uint(pmax), false, false);
      pmax = fmaxf(__uint_as_float(rr[0]), __uint_as_float(rr[1])); }
    constexpr float C2 = 1.4426950408889634f * SCALE;
    if (__builtin_expect(__all((pmax - m_reg) * SCALE <= THR), 1)) { mn = m_reg; alpha = 1.f; }
    else { mn = fmaxf(m_reg, pmax); alpha = __builtin_amdgcn_exp2f((m_reg - mn) * C2); m_reg = mn; }
    const float mnL = -mn * C2;
    for (int r = 0; r < 16; ++r) p0[r] = fmaf(p0[r], C2, mnL); for (int r = 0; r < 16; ++r) p1[r] = fmaf(p1[r], C2, mnL);
    for (int r = 0; r < 16; ++r) p0[r] = __builtin_amdgcn_exp2f(p0[r]);
}
__device__ __forceinline__ void finishSM(f32x16& p0, f32x16& p1, float alpha, float& l_reg, bf16x8& pa0, bf16x8& pa1, bf16x8& pa2, bf16x8& pa3) {
    for (int r = 0; r < 16; ++r) p1[r] = __builtin_amdgcn_exp2f(p1[r]);
    float ps = 0; for (int r = 0; r < 16; ++r) ps += p0[r]; for (int r = 0; r < 16; ++r) ps += p1[r];
    { auto rr = __builtin_amdgcn_permlane32_swap(__float_as_uint(ps), __float_as_uint(ps), false, false);
      ps = __uint_as_float(rr[0]) + __uint_as_float(rr[1]); }
    l_reg = l_reg * alpha + ps;
#define PK4(P, B_, OUT) do { unsigned a0 = cvtpk(P[B_+0], P[B_+1]), a1 = cvtpk(P[B_+2], P[B_+3]);                          \
        unsigned b0 = cvtpk(P[B_+4], P[B_+5]), b1 = cvtpk(P[B_+6], P[B_+7]);                                             \
        auto r0 = __builtin_amdgcn_permlane32_swap(a0, b0, false, false); auto r1 = __builtin_amdgcn_permlane32_swap(a1, b1, false, false); \
        u32x4 w = {r0[0], r1[0], r0[1], r1[1]}; OUT = *reinterpret_cast<bf16x8*>(&w); } while (0)
    PK4(p0, 0, pa0); PK4(p0, 8, pa1); PK4(p1, 0, pa2); PK4(p1, 8, pa3);
#undef PK4
}
template <int KB, bool SK>
__device__ __forceinline__ void qkt(f32x16& p0, f32x16& p1, const char* K_lds, int r32, int hi, const bf16x8* qr, bool act, float nsl, float dqf) {
    if (SK && !act) { const float NEG = -__builtin_inff();
#pragma unroll
        for (int r = 0; r < 16; ++r) { p0[r] = NEG; p1[r] = NEG; } return; }
#pragma unroll
    for (int r = 0; r < 16; ++r) { const float c = (float)((r & 3) + 8 * (r >> 2)); p0[r] = nsl * __builtin_fabsf(dqf - c); p1[r] = nsl * __builtin_fabsf(dqf - (c + 32.f)); }
    const char* kb[4];
#pragma unroll
    for (int dd = 0; dd < 4; ++dd) kb[dd] = K_lds + KB * SHM_K + KSWZ(r32, (dd * 16 + hi * 8) * 2);
#pragma unroll
    for (int d0 = 0; d0 < 8; ++d0) { const char* a = kb[d0 & 3] + (d0 >> 2) * 128;
        bf16x8 b0 = *reinterpret_cast<const bf16x8*>(a);
        bf16x8 b1 = *reinterpret_cast<const bf16x8*>(a + 32 * 256);
        p0 = __builtin_amdgcn_mfma_f32_32x32x16_bf16(b0, qr[d0], p0, 0, 0, 0);
        p1 = __builtin_amdgcn_mfma_f32_32x32x16_bf16(b1, qr[d0], p1, 0, 0, 0); }
}
template <int VB, bool SK>
__device__ __forceinline__ void pv_tile(f32x16* o, int vb0, bf16x8 pa0, bf16x8 pa1, bf16x8 pa2, bf16x8 pa3, bool act) {
    if (SK && !act) return;
#define TRRD(dst, off) asm volatile("ds_read_b64_tr_b16 %0, %1 offset:%2" : "=&v"(dst) : "v"(vb0), "i"(off) : "memory")
#define PV_D0(d0) do { s16x4 l0, l1, l2, l3, h0, h1, h2, h3; constexpr int b_ = VB * SHM_V + v_rd_off(d0, 0, 0);     \
        TRRD(l0, b_); TRRD(h0, b_ + 2048); TRRD(l1, b_ + 4096); TRRD(h1, b_ + 6144); TRRD(l2, b_ + 8192); TRRD(h2, b_ + 10240); TRRD(l3, b_ + 12288); TRRD(h3, b_ + 14336); \
        asm volatile("s_waitcnt lgkmcnt(0)" ::: "memory"); SBAR();                 \
        o[d0] = __builtin_amdgcn_mfma_f32_32x32x16_bf16(pa0, (bf16x8){l0[0], l0[1], l0[2], l0[3], h0[0], h0[1], h0[2], h0[3]}, o[d0], 0, 0, 0);   \
        o[d0] = __builtin_amdgcn_mfma_f32_32x32x16_bf16(pa1, (bf16x8){l1[0], l1[1], l1[2], l1[3], h1[0], h1[1], h1[2], h1[3]}, o[d0], 0, 0, 0);   \
        o[d0] = __builtin_amdgcn_mfma_f32_32x32x16_bf16(pa2, (bf16x8){l2[0], l2[1], l2[2], l2[3], h2[0], h2[1], h2[2], h2[3]}, o[d0], 0, 0, 0);   \
        o[d0] = __builtin_amdgcn_mfma_f32_32x32x16_bf16(pa3, (bf16x8){l3[0], l3[1], l3[2], l3[3], h3[0], h3[1], h3[2], h3[3]}, o[d0], 0, 0, 0); } while (0)
    PV_D0(0); PV_D0(1); PV_D0(2); PV_D0(3);
#undef PV_D0
#undef TRRD
}

template <class TIn, class TOut> struct BlockRef { const TIn* Q; const TIn* K; const TIn* V; TOut* O; int P0; int W; float nsl; };
template <class TIn> struct Seam {
    bf16x8 qr[8];
    bf16x8 st_v0, st_v1, st_k0, st_k1; f32x4 sf0, sf1, sf2, sf3;
    f32x4 tq[16];
};
__device__ __forceinline__ int swa_jlo(int P0, int W) { const int lowk = P0 - W + 1; return lowk > 0 ? lowk / KVBLK : 0; }
#define ROW(p, k0, rr) ((p) + (size_t)((k0) + (rr)) * D + sc)
#define VMW() asm volatile("s_waitcnt vmcnt(0)" ::: "memory")
#define VMWN(n) asm volatile("s_waitcnt vmcnt(%0)" :: "i"(n) : "memory")
#define SLOAD_H(Kp, Vp, k0) do { S.st_v0 = load8<TIn>(ROW(Vp, k0, sr)); S.st_v1 = load8<TIn>(ROW(Vp, k0, 32 + sr));              \
                         S.st_k0 = load8<TIn>(ROW(Kp, k0, sr)); S.st_k1 = load8<TIn>(ROW(Kp, k0, 32 + sr)); } while (0)
#define SWRITE_HK(bf) do { *(bf16x8*)(K_lds + (bf) * SHM_K + kws) = S.st_k0; *(bf16x8*)(K_lds + (bf) * SHM_K + kws + 32 * 256) = S.st_k1; } while (0)
#define SWRITE_HV(bf) do { *(bf16x8*)(V_lds + (bf) * SHM_V + vst0) = S.st_v0; *(bf16x8*)(V_lds + (bf) * SHM_V + vst1) = S.st_v1; } while (0)
#define SWRITE_H(bf) do { SWRITE_HV(bf); SWRITE_HK(bf); } while (0)
#define SLOAD_F(p, k0) do { S.sf0 = *(const f32x4*)ROW(p, k0, sr); S.sf1 = *(const f32x4*)(ROW(p, k0, sr) + 4);                \
                            S.sf2 = *(const f32x4*)ROW(p, k0, 32 + sr); S.sf3 = *(const f32x4*)(ROW(p, k0, 32 + sr) + 4); } while (0)
#define SWRITE_KF(bf) do { *(bf16x8*)(K_lds + (bf) * SHM_K + kws) = pack8(S.sf0, S.sf1); *(bf16x8*)(K_lds + (bf) * SHM_K + kws + 32 * 256) = pack8(S.sf2, S.sf3); } while (0)
#define SWRITE_VF(bf) do { *(bf16x8*)(V_lds + (bf) * SHM_V + vst0) = pack8(S.sf0, S.sf1); *(bf16x8*)(V_lds + (bf) * SHM_V + vst1) = pack8(S.sf2, S.sf3); } while (0)
template <class TIn, class TOut>
__device__ __forceinline__ void causal_swa_prime(const BlockRef<TIn, TOut>& cur, char* lds, Seam<TIn>& S) {
    constexpr bool F32 = same_t<TIn, float>::v;
    const int tid = otid(), wid = __builtin_amdgcn_readfirstlane(tid >> 6), lane = tid & 63, r32 = lane & 31, hi = lane >> 5;
    const int sr = tid >> 4, sc = (tid & 15) * 8, kws = KSWZ(sr, sc * 2); char* K_lds = lds + 2 * SHM_V;
    const int kb0 = swa_jlo(cur.P0, cur.W) * KVBLK;
    for (int d0 = 0; d0 < 8; ++d0) S.qr[d0] = load8<TIn>(cur.Q + (size_t)(wid * QBLK + r32) * D + d0 * 16 + hi * 8);
    if constexpr (F32) { SLOAD_F((const float*)cur.K, kb0); VMW(); SWRITE_KF(0); SBAR(); SLOAD_F((const float*)cur.V, kb0); }
    else { SLOAD_H(cur.K, cur.V, kb0); VMW(); SWRITE_HK(0); }
    __syncthreads();
}
template <class TIn, class TOut>
__device__ __forceinline__ void causal_swa_block(const BlockRef<TIn, TOut>& cur, const BlockRef<TIn, TOut>& nxt, int skv, char* lds, Seam<TIn>& S) {
    constexpr bool F32 = same_t<TIn, float>::v;
    const int tid = otid(), wid = __builtin_amdgcn_readfirstlane(tid >> 6), lane = tid & 63, r32 = lane & 31, hi = lane >> 5;
    const int j_lo = swa_jlo(cur.P0, cur.W); const float nsl = cur.nsl;
    int j_hi = (cur.P0 + QB - 1) / KVBLK + 1; if (j_hi > skv / KVBLK) j_hi = skv / KVBLK;
    const int NT = j_hi - j_lo;
    const int kbn = swa_jlo(nxt.P0, nxt.W) * KVBLK;
    const int qlo = cur.P0 + wid * QBLK, qlom = qlo | 63, qm = ((qlo + r32) | 63) - 4 * hi, qt4 = qlo + r32 - 4 * hi;
    char* V_lds = lds; char* K_lds = lds + 2 * SHM_V;
    float* ws = (float*)(lds + 2 * SHM_V + 2 * SHM_K) + wid * 64; float* li_l = ws, * al_l = ws + 32;
    float m_reg = -1e30f, l_reg = 0; f32x16 o[4] = {};
    const int sr = tid >> 4, sc = (tid & 15) * 8, vst0 = v_st(sr, sc), vst1 = v_st(32 + sr, sc), kws = KSWZ(sr, sc * 2);
    const int vb0 = (int)(uintptr_t)V_lds + v_rd_base(lane);
    const TIn* Kh = cur.K; const TIn* Vh = cur.V;
#define RESC(a) do { if (__any((a) < 1.f)) { if (hi == 0) al_l[r32] = (a); asm volatile("s_waitcnt lgkmcnt(0)" ::: "memory");              \
                     for (int d_ = 0; d_ < 4; ++d_) for (int r = 0; r < 16; ++r) o[d_][r] *= al_l[crow(r, hi)]; } } while (0)
#define KBASE(t) ((j_lo + (t)) * KVBLK)
#define ACT(t) (true)
#define MASKT(P0_, P1_, t) do { const int kb_ = KBASE(t); if (kb_ + KVBLK - 1 > qlom) mask_tile(P0_, P1_, qm - kb_, 0x40000000u); } while (0)
    constexpr int NQL = F32 ? 16 : 8;
    constexpr bool SK = WSKIP && !F32;
#define SEAM_K0() do { VMWN(NQL); if constexpr (F32) { SWRITE_KF(0); SBAR(); SLOAD_F((const float*)nxt.V, kbn); } else { SWRITE_HK(0); } SBAR(); } while (0)
    f32x16 pA0, pA1, pB0, pB1; float mnA, mnB, alA, alB; bf16x8 pa0, pa1, pa2, pa3;
    if constexpr (F32) { VMW(); SWRITE_VF(0); SBAR(); } else { SWRITE_HV(0); SBAR(); }
    if (NT > 1) { if constexpr (F32) SLOAD_F((const float*)Kh, KBASE(1)); else SLOAD_H(Kh, Vh, KBASE(1)); }
    SBAR(); qkt<0, SK>(pA0, pA1, K_lds, r32, hi, S.qr, ACT(0), nsl, (float)(qt4 - KBASE(0)));
    if constexpr (F32) { if (NT > 1) { VMW(); SWRITE_KF(1); SBAR(); SLOAD_F((const float*)Vh, KBASE(1)); } }
    MASKT(pA0, pA1, 0); partialSM(pA0, pA1, m_reg, mnA, alA);
    if (NT > 1) { VMW(); if constexpr (F32) { SWRITE_VF(1); SBAR(); if (NT > 2) SLOAD_F((const float*)Kh, KBASE(2)); } else SWRITE_H(1); }
    __syncthreads();
#define HALF_STEP(PX0, PX1, mnX, alX, PY0, PY1, alY, t, KB, VB, SB) do {                                                      \
        SBAR(); qkt<KB, SK>(PX0, PX1, K_lds, r32, hi, S.qr, ACT(t), nsl, (float)(qt4 - KBASE(t)));                                             \
        finishSM(PY0, PY1, alY, l_reg, pa0, pa1, pa2, pa3); SBAR();                                                           \
        if ((t) + 1 < NT) { if constexpr (F32) { VMW(); SWRITE_KF(SB); SBAR(); SLOAD_F((const float*)Vh, KBASE((t) + 1)); }  \
                            else { SLOAD_H(Kh, Vh, KBASE((t) + 1)); } SBAR(); }                                               \
        pv_tile<VB, SK>(o, vb0, pa0, pa1, pa2, pa3, ACT((t) - 1)); MASKT(PX0, PX1, (t)); partialSM(PX0, PX1, m_reg, mnX, alX);                                        \
        __syncthreads();                                                                                                      \
        if ((t) + 1 < NT) { VMW(); if constexpr (F32) { SWRITE_VF(SB); SBAR(); if ((t) + 2 < NT) SLOAD_F((const float*)Kh, KBASE((t) + 2)); } \
                            else { SWRITE_H(SB); } }                                                                          \
        RESC(alX); __syncthreads(); } while (0)
    for (int t = 1; t + 1 < NT; t += 2) {
        HALF_STEP(pB0, pB1, mnB, alB, pA0, pA1, alA, t, 1, 0, 0);
        HALF_STEP(pA0, pA1, mnA, alA, pB0, pB1, alB, t + 1, 0, 1, 1);
    }
    const bool even = (NT & 1) == 0;
    if (even) { SBAR(); qkt<1, SK>(pB0, pB1, K_lds, r32, hi, S.qr, ACT(NT - 1), nsl, (float)(qt4 - KBASE(NT - 1))); SBAR(); }
#define QROW(e) (nxt.Q + (size_t)(wid * QBLK + r32) * D + ((e) >> 1) * 16 + hi * 8 + ((e) & 1) * 4)
    if constexpr (F32) { SLOAD_F((const float*)nxt.K, kbn); SBAR();
#pragma unroll
        for (int e = 0; e < 8; ++e) S.tq[e] = *(const f32x4*)QROW(e); }
    else { SLOAD_H(nxt.K, nxt.V, kbn); SBAR();
#pragma unroll
        for (int d0 = 0; d0 < 8; ++d0) S.qr[d0] = load8<TIn>(nxt.Q + (size_t)(wid * QBLK + r32) * D + d0 * 16 + hi * 8); }
    SBAR();
    finishSM(pA0, pA1, alA, l_reg, pa0, pa1, pa2, pa3); SBAR();
    if constexpr (F32) {
#pragma unroll
        for (int e = 8; e < 16; ++e) S.tq[e] = *(const f32x4*)QROW(e); SBAR(); }
#undef QROW
    pv_tile<0, SK>(o, vb0, pa0, pa1, pa2, pa3, ACT(even ? NT - 2 : NT - 1));
    if (even) { MASKT(pB0, pB1, NT - 1); partialSM(pB0, pB1, m_reg, mnB, alB); __syncthreads(); RESC(alB);
        finishSM(pB0, pB1, alB, l_reg, pa0, pa1, pa2, pa3); SBAR(); pv_tile<1, SK>(o, vb0, pa0, pa1, pa2, pa3, ACT(NT - 1)); }
    SBAR(); SEAM_K0();
    if (hi == 0) li_l[r32] = l_reg; asm volatile("s_waitcnt lgkmcnt(0)" ::: "memory");
    float rli[16];
#pragma unroll
    for (int r = 0; r < 16; ++r) rli[r] = __builtin_amdgcn_rcpf(li_l[crow(r, hi)]);
    TOut* Ow = cur.O + (size_t)(wid * QBLK) * D;
#pragma unroll
    for (int r = 0; r < 16; ++r) { const int orow = crow(r, hi);
#pragma unroll
        for (int d0 = 0; d0 < 4; ++d0) { const float v = o[d0][r] * rli[r];
            if constexpr (same_t<TOut, float>::v) { Ow[(size_t)orow * D + d0 * 32 + r32] = v; }
            else { const float vn = __shfl_xor(v, 1);
                   if ((r32 & 1) == 0) *(unsigned*)(Ow + (size_t)orow * D + d0 * 32 + r32) = cvtpk(v, vn); } } }
    if constexpr (F32) {
#pragma unroll
        for (int d0 = 0; d0 < 8; ++d0) S.qr[d0] = pack8(S.tq[2 * d0], S.tq[2 * d0 + 1]); }
    __syncthreads();
#undef RESC
#undef KBASE
#undef ACT
#undef MASKT
#undef SEAM_K0
#undef HALF_STEP
}
#undef ROW
#undef VMW
#undef VMWN
#undef SLOAD_H
#undef SWRITE_HK
#undef SWRITE_HV
#undef SWRITE_H
#undef SLOAD_F
#undef SWRITE_KF
#undef SWRITE_VF

}
#ifndef MK_PER_PHASE
#define MK_PER_PHASE 0
#endif
#define MK_PH_HI 16
#ifndef MK_GDN_SIMPLE
#define MK_GDN_SIMPLE 1
#endif

#define LAS __attribute__((address_space(3)))
typedef unsigned short u16;
typedef short v8s __attribute__((ext_vector_type(8)));
typedef float v4f __attribute__((ext_vector_type(4)));
typedef float v16f __attribute__((ext_vector_type(16)));
typedef unsigned v4u __attribute__((ext_vector_type(4)));
typedef unsigned v2u __attribute__((ext_vector_type(2)));

constexpr int S_ = 8192, DM = 2048, NQKV = 6144, DFF = 5504, NUP = 11008, GIN = 12352, GINP = 12544, GV = 4096;
constexpr float EPS = 1e-6f;
constexpr size_t MiB = 1u << 20;
constexpr size_t WS_MISC = 0;
constexpr size_t WS_WUP1 = 1 * MiB, WS_WDN1 = 44 * MiB, WS_WIN = 66 * MiB, WS_WOUT = 115 * MiB;
constexpr size_t WS_XB = 131 * MiB;
constexpr size_t WS_WQKV = 163 * MiB, WS_WO = 187 * MiB, WS_WUP0 = 195 * MiB, WS_WDN0 = 238 * MiB;
constexpr size_t WS_QH = 260 * MiB, WS_KH = 292 * MiB, WS_VH = 324 * MiB, WS_OATT = 356 * MiB, WS_OB = 484 * MiB;
constexpr size_t WS_U = 260 * MiB, WS_Y = 432 * MiB;
constexpr size_t WS_PQKV = 163 * MiB, WS_Z = 291 * MiB, WS_BA = 355 * MiB, WS_OPS = 357 * MiB;
constexpr size_t WS_OG = WS_PQKV;
constexpr size_t WS_OGN = WS_OPS;
constexpr size_t WS_SSQ = 652 * MiB;
constexpr size_t WS_END = 656 * MiB;
static_assert(WS_KH - WS_QH == 32 * MiB && WS_VH - WS_KH == 32 * MiB, "EpiQKV tensor stride");
constexpr int OPS_BLK = 73984, OP_GL = 73728;
constexpr int OP_W = 0, OP_QD = 16384, OP_QK = 32768, OP_KD = 40960, OP_U = 57344;
constexpr int SCAN_BUF = 61440;
constexpr int LDS_BYTES = 139264;
constexpr int XCH_OFF = 131072;

__device__ __forceinline__ unsigned cvtpk(float lo, float hi) { unsigned r; asm volatile("v_cvt_pk_bf16_f32 %0, %1, %2" : "=v"(r) : "v"(lo), "v"(hi)); return r; }
__device__ __forceinline__ u16 f2bf(float f) { return (u16)(cvtpk(f, 0.f) & 0xffffu); }
__device__ __forceinline__ float bf2f(u16 b) { return __uint_as_float(((unsigned)b) << 16); }
__device__ __forceinline__ float bflo(unsigned w) { return __uint_as_float(w << 16); }
__device__ __forceinline__ float bfhi(unsigned w) { return __uint_as_float(w & 0xffff0000u); }
__device__ __forceinline__ v8s pack8f(float a0, float a1, float a2, float a3, float a4, float a5, float a6, float a7) {
    v4u w = {cvtpk(a0, a1), cvtpk(a2, a3), cvtpk(a4, a5), cvtpk(a6, a7)}; return *reinterpret_cast<v8s*>(&w); }
__device__ __forceinline__ float wave_sum(float v) {
#pragma unroll
    for (int o = 1; o < 64; o <<= 1) v += __shfl_xor(v, o);
    return v; }
__device__ __forceinline__ float silu_f(float y) { return y / (1.f + __expf(-y)); }
#define LDS_WAIT() asm volatile("s_waitcnt lgkmcnt(0)" ::: "memory")
#define VM_WAIT() asm volatile("s_waitcnt vmcnt(0)" ::: "memory")

struct Params { const float* in[22]; float* out; unsigned char* ws; int ph_lo, ph_hi; };
struct EpiQKV {
    static constexpr bool PERM = true, AFTER_DRAIN = false;
    u16* Qh;
    __device__ __forceinline__ void operator()(const pg8::f32x4 (&acc)[2][2][4][2], const pg8::Unit& u, int wr, int wc, int fr, int fq) const {
        asm volatile("" : "+v"(fr), "+v"(fq));
        const int tensor = u.pn >> 3, hh0 = 2 * (u.pn & 7);
        u16* T = Qh + (size_t)tensor * (16u << 20);
        const int cl = wc * 32 + fq * 8;
#pragma unroll
        for (int ai = 0; ai < 2; ++ai)
#pragma unroll
            for (int m = 0; m < 4; ++m) {
                const size_t row = (size_t)u.pm * 256 + ai * 128 + wr * 64 + m * 16 + fr;
#pragma unroll
                for (int bj = 0; bj < 2; ++bj) {
                    const pg8::f32x4 a = acc[ai][bj][m][0], b = acc[ai][bj][m][1];
                    v4u w; w.x = cvtpk(a[0], a[1]); w.y = cvtpk(a[2], a[3]); w.z = cvtpk(b[0], b[1]); w.w = cvtpk(b[2], b[3]);
                    *(v4u*)(T + ((size_t)(hh0 + bj) * S_ + row) * 128 + cl) = w;
                }
            }
    }
};
__device__ __forceinline__ void phase_qknorm(const Params& p) {
    const int tid = otid(), lane = tid & 63, wave = tid >> 6;
    const int gw = blockIdx.x * 8 + wave, NGW = gridDim.x * 8;
    u16* QK = (u16*)(p.ws + WS_QH);
    const int e0 = 4 * (lane & 31);
    for (int it = gw; it < 2 * 16 * S_ / 2; it += NGW) {
        const size_t r = (size_t)it * 2 + (lane >> 5);
        const int tensor = (int)(r >> 17);
        const v4f g = *(const v4f*)((tensor ? p.in[5] : p.in[4]) + e0);
        u16* ptr = QK + r * 128 + e0;
        const v2u w = *(const v2u*)ptr;
        const float x0 = bflo(w.x), x1 = bfhi(w.x), x2 = bflo(w.y), x3 = bfhi(w.y);
        float ss = (x0 * x0 + x1 * x1) + (x2 * x2 + x3 * x3);
#pragma unroll
        for (int o = 1; o < 32; o <<= 1) ss += __shfl_xor(ss, o);
        const float rs = __builtin_amdgcn_rsqf(ss * (1.f / 128.f) + EPS);
        v2u o2; o2.x = cvtpk(x0 * rs * g[0], x1 * rs * g[1]); o2.y = cvtpk(x2 * rs * g[2], x3 * rs * g[3]);
        *(v2u*)ptr = o2;
    }
}
struct EpiRes {
    static constexpr bool PERM = false, AFTER_DRAIN = false;
    const float* base; float* out; u16* xb; float* ssq;
    __device__ __forceinline__ void operator()(const pg8::f32x4 (&acc)[2][2][4][2], const pg8::Unit& u, int wr, int wc, int fr, int fq) const {
        asm volatile("" : "+v"(fr), "+v"(fq));
        const int col0 = u.pn * 256 + wc * 32 + 4 * fq;
#pragma unroll
        for (int ai = 0; ai < 2; ++ai)
#pragma unroll
            for (int m = 0; m < 4; ++m) {
                const size_t row = (size_t)u.pm * 256 + ai * 128 + wr * 64 + m * 16 + fr; const size_t off = row * DM + col0; float s = 0.f;
#pragma unroll
                for (int bj = 0; bj < 2; ++bj)
#pragma unroll
                    for (int n = 0; n < 2; ++n) {
                        const size_t o = off + bj * 128 + n * 16;
                        const v4f bs = *(const v4f*)(base + o); const pg8::f32x4 a = acc[ai][bj][m][n];
                        v4f v; v[0] = bs[0] + a[0]; v[1] = bs[1] + a[1]; v[2] = bs[2] + a[2]; v[3] = bs[3] + a[3];
                        *(v4f*)(out + o) = v;
                        if (xb) { v2u w; w.x = cvtpk(v[0], v[1]); w.y = cvtpk(v[2], v[3]); *(v2u*)(xb + o) = w; }
                        s += (v[0] * v[0] + v[1] * v[1]) + (v[2] * v[2] + v[3] * v[3]);
                    }
                if (ssq) { s += __shfl_xor(s, 16); s += __shfl_xor(s, 32); if (fq == 0) ssq[((size_t)u.pn * S_ + row) * 4 + wc] = s; }
            }
    }
};
struct EpiScale {
    static constexpr bool PERM = true, AFTER_DRAIN = false;
    const float* ssq; u16* O0; int ld0; int n0;
    u16* O1; int ld1; int n1;
    float* O2; int ld2; int n2;
    __device__ __forceinline__ void operator()(const pg8::f32x4 (&acc)[2][2][4][2], const pg8::Unit& u, int wr, int wc, int fr, int fq) const {
        asm volatile("" : "+v"(fr), "+v"(fq));
        const int colt = u.pn * 256; const int cl = wc * 32 + fq * 8;
#pragma unroll
        for (int ai = 0; ai < 2; ++ai)
#pragma unroll
            for (int m = 0; m < 4; ++m) {
                const size_t row = (size_t)u.pm * 256 + ai * 128 + wr * 64 + m * 16 + fr;
                float sq = 0.f;
#pragma unroll
                for (int t = 0; t < 8; ++t) { const v4f q4 = *(const v4f*)(ssq + ((size_t)t * S_ + row) * 4); sq += (q4[0] + q4[1]) + (q4[2] + q4[3]); }
                const float rs = __builtin_amdgcn_rsqf(sq * (1.f / 2048.f) + EPS);
#pragma unroll
                for (int bj = 0; bj < 2; ++bj) {
                    const int col = colt + bj * 128 + cl;
                    const pg8::f32x4 a = acc[ai][bj][m][0], b = acc[ai][bj][m][1];
                    if (colt < n1) {
                        v4u w; w.x = cvtpk(a[0] * rs, a[1] * rs); w.y = cvtpk(a[2] * rs, a[3] * rs); w.z = cvtpk(b[0] * rs, b[1] * rs); w.w = cvtpk(b[2] * rs, b[3] * rs);
                        if (colt < n0) *(v4u*)(O0 + row * ld0 + col) = w; else *(v4u*)(O1 + row * ld1 + (col - n0)) = w;
                    } else if (col < n2) {
                        float* p = O2 + row * ld2 + (col - n1);
                        v4f x = {a[0] * rs, a[1] * rs, a[2] * rs, a[3] * rs}, y = {b[0] * rs, b[1] * rs, b[2] * rs, b[3] * rs};
                        *(v4f*)p = x; *(v4f*)(p + 4) = y;
                    }
                }
            }
    }
};

__device__ __forceinline__ void transpose_item(const float* W, int K, int N, u16* WT, const float* gain, LAS float* scr, int item, int lane) {
    const int nblk = N / 32, kb = item / nblk, nb = item % nblk, k0 = 64 * kb, n0 = 32 * nb;
#pragma unroll 8
    for (int i = 0; i < 32; ++i) { const int kk = 2 * i + (lane >> 5); float v = W[(size_t)(k0 + kk) * N + n0 + (lane & 31)]; if (gain) v *= gain[k0 + kk]; scr[kk * 33 + (lane & 31)] = v; }
    LDS_WAIT(); asm volatile("" ::: "memory");
    const int c = lane & 7;
#pragma unroll
    for (int j = 0; j < 4; ++j) { const int n = (lane >> 3) + 8 * j; const LAS float* s = scr + (8 * c) * 33 + n;
        v4u o; o.x = cvtpk(s[0 * 33], s[1 * 33]); o.y = cvtpk(s[2 * 33], s[3 * 33]); o.z = cvtpk(s[4 * 33], s[5 * 33]); o.w = cvtpk(s[6 * 33], s[7 * 33]);
        *(v4u*)(WT + (size_t)(n0 + n) * K + k0 + 8 * c) = o; }
    LDS_WAIT(); asm volatile("" ::: "memory");
}

__device__ __forceinline__ void phase_p0(const Params& p, LAS unsigned char* lds) {
    const int tid = otid(), lane = tid & 63, wave = tid >> 6;
    LAS float* scr = (LAS float*)(lds + wave * 16384);
    const int gw = blockIdx.x * 8 + wave, NGW = gridDim.x * 8;
    unsigned char* ws = p.ws;
    constexpr int I_QKV = 32 * 192, I_O = 32 * 64, I_UP = 32 * 344, I_DN = 86 * 64, I_IN = 32 * 386, I_OUT = 64 * 64;
    constexpr int NIT = I_QKV + I_O + 2 * I_UP + 2 * I_DN + I_IN + I_OUT;
    for (int it = gw; it < NIT; it += NGW) {
        int r = it;
        if (r < I_QKV) { transpose_item(p.in[3], DM, NQKV, (u16*)(ws + WS_WQKV), nullptr, scr, r, lane); continue; } r -= I_QKV;
        if (r < I_O) { transpose_item(p.in[11], DM, DM, (u16*)(ws + WS_WO), nullptr, scr, r, lane); continue; } r -= I_O;
        if (r < I_UP) { transpose_item(p.in[18], DM, NUP, (u16*)(ws + WS_WUP0), p.in[2], scr, r, lane); continue; } r -= I_UP;
        if (r < I_UP) { transpose_item(p.in[18] + (size_t)DM * NUP, DM, NUP, (u16*)(ws + WS_WUP1), p.in[2] + DM, scr, r, lane); continue; } r -= I_UP;
        if (r < I_DN) { transpose_item(p.in[21], DFF, DM, (u16*)(ws + WS_WDN0), nullptr, scr, r, lane); continue; } r -= I_DN;
        if (r < I_DN) { transpose_item(p.in[21] + (size_t)DFF * DM, DFF, DM, (u16*)(ws + WS_WDN1), nullptr, scr, r, lane); continue; } r -= I_DN;
        if (r < I_IN) { transpose_item(p.in[12], DM, GIN, (u16*)(ws + WS_WIN), p.in[1] + DM, scr, r, lane); continue; } r -= I_IN;
        transpose_item(p.in[17], GV, DM, (u16*)(ws + WS_WOUT), nullptr, scr, r, lane);
    }
    { const size_t gt = (size_t)blockIdx.x * 512 + tid, NT = (size_t)gridDim.x * 512;
      v4u z = {0u, 0u, 0u, 0u}; v4u* pz = (v4u*)(ws + WS_WIN + (size_t)GIN * DM * 2);
      for (size_t i = gt; i < (size_t)(GINP - GIN) * DM * 2 / 16; i += NT) pz[i] = z;
    }
    const float* x = p.in[0]; const float* g = p.in[1]; u16* xb = (u16*)(ws + WS_XB);
    for (int row = gw; row < S_; row += NGW) {
        const v4f* xr = (const v4f*)(x + (size_t)row * DM) + lane; v4f v[8]; float s = 0.f;
#pragma unroll
        for (int j = 0; j < 8; ++j) { v[j] = xr[64 * j]; s += (v[j][0] * v[j][0] + v[j][1] * v[j][1]) + (v[j][2] * v[j][2] + v[j][3] * v[j][3]); }
        const float rs = __builtin_amdgcn_rsqf(wave_sum(s) * (1.f / DM) + EPS);
#pragma unroll
        for (int j = 0; j < 8; ++j) { const v4f gg = *((const v4f*)g + lane + 64 * j);
            v2u w; w.x = cvtpk(v[j][0] * rs * gg[0], v[j][1] * rs * gg[1]); w.y = cvtpk(v[j][2] * rs * gg[2], v[j][3] * rs * gg[3]);
            *((v2u*)(xb + (size_t)row * DM) + lane + 64 * j) = w; }
    }
}

__device__ __forceinline__ att::BlockRef<att::bf16, float> attn_ref(int m32, int qb, const u16* Qh, const u16* Kh, const u16* Vh, float* O) {
    const int map = m32 >> 1, c = m32 & 1, h = map >> 1;
    att::BlockRef<att::bf16, float> r;
    r.Q = (const att::bf16*)(Qh + ((size_t)map * S_ + (size_t)qb * 256) * 128);
    r.K = (const att::bf16*)(Kh + (size_t)map * S_ * 128);
    r.V = (const att::bf16*)(Vh + (size_t)(h * 2 + c) * S_ * 128);
    r.O = O + ((size_t)m32 * S_ + (size_t)qb * 256) * 128;
    r.P0 = qb * 256; r.W = 1 << 30;
    r.nsl = -__builtin_amdgcn_exp2f(-(float)(h + 1)) * 11.313708498984761f;
    return r;
}
struct AttItem { int m32, qb0, qb1; };
__device__ __forceinline__ AttItem attn_decode(int L) {
    const int xcd = L & 7, k = L >> 3, gi = k >> 4, r = k & 15; AttItem it;
    it.m32 = (xcd + 8 * (gi >> 1)) * 2 + (gi & 1); it.qb0 = r; it.qb1 = 31 - r; return it;
}
__device__ __forceinline__ void phase_attn(const Params& p, char* lds) {
    const u16* Qh = (const u16*)(p.ws + WS_QH); const u16* Kh = (const u16*)(p.ws + WS_KH); const u16* Vh = (const u16*)(p.ws + WS_VH); float* O = (float*)(p.ws + WS_OATT);
    constexpr int total = 512; const int stride = gridDim.x;
    int L = blockIdx.x; if (L >= total) return;
    AttItem it = attn_decode(L); int pass = 0;
    att::BlockRef<att::bf16, float> cur = attn_ref(it.m32, it.qb0, Qh, Kh, Vh, O);
    att::Seam<att::bf16> S;
    att::causal_swa_prime<att::bf16, float>(cur, lds, S);
    for (;;) {
        const bool more_pass = pass == 0, more_item = L + stride < total, last = !more_pass && !more_item;
        AttItem itn = it; int passn = pass + 1, Ln = L;
        if (!more_pass) { passn = 0; Ln = more_item ? L + stride : L; itn = attn_decode(Ln); }
        const att::BlockRef<att::bf16, float> nxt = last ? cur : attn_ref(itn.m32, passn ? itn.qb1 : itn.qb0, Qh, Kh, Vh, O);
        att::causal_swa_block<att::bf16, float>(cur, nxt, S_, lds, S);
        if (last) break;
        cur = nxt; it = itn; pass = passn; L = Ln;
    }
}
__device__ __forceinline__ void phase_combine(const Params& p) {
    const int tid = otid(), lane = tid & 63, wave = tid >> 6;
    const int gw = blockIdx.x * 8 + wave, NGW = gridDim.x * 8;
    float s1 = p.in[6][lane] * p.in[7][lane] + p.in[6][lane + 64] * p.in[7][lane + 64];
    float s2 = p.in[8][lane] * p.in[9][lane] + p.in[8][lane + 64] * p.in[9][lane + 64];
    s1 = wave_sum(s1); s2 = wave_sum(s2);
    const float lam = __expf(s1) - __expf(s2) + 0.2f;
    const float* O = (const float*)(p.ws + WS_OATT); u16* OB = (u16*)(p.ws + WS_OB);
    const int e0 = 4 * lane, c = e0 >> 7, wi = e0 & 127;
    const v4f sg = *(const v4f*)(p.in[10] + e0);
    for (int it = gw; it < S_ * 8; it += NGW) {
        const int t = it >> 3, h = it & 7;
        const v4f a = *(const v4f*)(O + ((size_t)((4 * h + c)) * S_ + t) * 128 + wi);
        const v4f b = *(const v4f*)(O + ((size_t)((4 * h + 2 + c)) * S_ + t) * 128 + wi);
        v4f v; v[0] = a[0] - lam * b[0]; v[1] = a[1] - lam * b[1]; v[2] = a[2] - lam * b[2]; v[3] = a[3] - lam * b[3];
        const float ss = wave_sum((v[0] * v[0] + v[1] * v[1]) + (v[2] * v[2] + v[3] * v[3]));
        const float rs = __builtin_amdgcn_rsqf(ss * (1.f / 256.f) + EPS) * 0.8f;
        v2u w; w.x = cvtpk(v[0] * rs * sg[0], v[1] * rs * sg[1]); w.y = cvtpk(v[2] * rs * sg[2], v[3] * rs * sg[3]);
        *(v2u*)(OB + (size_t)t * DM + h * 256 + e0) = w;
    }
}

__device__ __forceinline__ void unpack8(const v4u w, float (&f)[8]) { f[0] = bflo(w.x); f[1] = bfhi(w.x); f[2] = bflo(w.y); f[3] = bfhi(w.y); f[4] = bflo(w.z); f[5] = bfhi(w.z); f[6] = bflo(w.w); f[7] = bfhi(w.w); }
__device__ __forceinline__ void phase_convgate(const Params& p, int layer) {
    const u16* U = (const u16*)(p.ws + WS_U); u16* Y = (u16*)(p.ws + WS_Y);
    const float* cw = p.in[19] + (size_t)layer * 3 * NUP; const float* cb = p.in[20] + (size_t)layer * NUP;
    constexpr int NCG = DFF / 8, RUN = 32, NRUN = S_ / RUN;
    const size_t gt = (size_t)blockIdx.x * 512 + otid(), NT = (size_t)gridDim.x * 512;
    for (size_t idx = gt; idx < (size_t)NCG * NRUN; idx += NT) {
        const int cg8 = (int)(idx % NCG) * 8, t0 = (int)(idx / NCG) * RUN;
        float wv[3][8], wg[3][8], bv[8], bg[8];
#pragma unroll
        for (int j = 0; j < 3; ++j)
#pragma unroll
            for (int e = 0; e < 8; ++e) { wv[j][e] = cw[j * NUP + cg8 + e]; wg[j][e] = cw[j * NUP + DFF + cg8 + e]; }
#pragma unroll
        for (int e = 0; e < 8; ++e) { bv[e] = cb[cg8 + e]; bg[e] = cb[DFF + cg8 + e]; }
        float v2[8], v1[8], g2[8], g1[8];
#pragma unroll
        for (int e = 0; e < 8; ++e) { v2[e] = v1[e] = g2[e] = g1[e] = 0.f; }
        if (t0 >= 2) {
            unpack8(*(const v4u*)(U + (size_t)(t0 - 2) * NUP + cg8), v2); unpack8(*(const v4u*)(U + (size_t)(t0 - 1) * NUP + cg8), v1);
            unpack8(*(const v4u*)(U + (size_t)(t0 - 2) * NUP + DFF + cg8), g2); unpack8(*(const v4u*)(U + (size_t)(t0 - 1) * NUP + DFF + cg8), g1);
        }
#pragma unroll 4
        for (int t = t0; t < t0 + RUN; ++t) {
            float v0[8], g0[8];
            unpack8(*(const v4u*)(U + (size_t)t * NUP + cg8), v0); unpack8(*(const v4u*)(U + (size_t)t * NUP + DFF + cg8), g0);
            float y[8];
#pragma unroll
            for (int e = 0; e < 8; ++e) {
                const float val = wv[0][e] * v2[e] + wv[1][e] * v1[e] + wv[2][e] * v0[e] + bv[e];
                const float gat = wg[0][e] * g2[e] + wg[1][e] * g1[e] + wg[2][e] * g0[e] + bg[e];
                y[e] = silu_f(gat) * val; v2[e] = v1[e]; v1[e] = v0[e]; g2[e] = g1[e]; g1[e] = g0[e];
            }
            v4u w = {cvtpk(y[0], y[1]), cvtpk(y[2], y[3]), cvtpk(y[4], y[5]), cvtpk(y[6], y[7])};
            *(v4u*)(Y + (size_t)t * DFF + cg8) = w;
        }
    }
}

__device__ __forceinline__ int crow(int r, int hi) { return (r & 3) + 8 * (r >> 2) + 4 * hi; }
__device__ __forceinline__ v16f mm_tile(v16f c, const LAS u16* A, int lda, const LAS u16* Bt, int ldb, int K, int lane) {
    const int m = lane & 31, hi = lane >> 5;
    for (int k0 = 0; k0 < K; k0 += 16) {
        const v8s a = *(const LAS v8s*)(A + m * lda + k0 + 8 * hi); const v8s b = *(const LAS v8s*)(Bt + m * ldb + k0 + 8 * hi);
        c = __builtin_amdgcn_mfma_f32_32x32x16_bf16(a, b, c, 0, 0, 0);
    }
    return c;
}
constexpr int PL_KB = 0, PL_QB = 17408, PL_KK = 34816, PL_QK = 51456, PL_GT = 68096, PL_HD = 69632;
constexpr int PL_KBE = PL_HD, PL_VBT = PL_HD + 18432, PL_PB = PL_HD + 36864, PL_PBT = PL_HD + 46080, PL_TB = PL_HD + 55296;
constexpr int PL_XQ = PL_HD, PL_XK = PL_HD + 33024;
static_assert(PL_XK + 33024 <= LDS_BYTES, "prep LDS");

__device__ __forceinline__ void phase_gdn_prep(const Params& p, LAS unsigned char* lds) {
    const int tid = otid(), lane = tid & 63, wave = __builtin_amdgcn_readfirstlane(tid >> 6), n = lane & 31, hi = lane >> 5;
    const u16* PQ = (const u16*)(p.ws + WS_PQKV); const float* BA = (const float*)(p.ws + WS_BA);
    unsigned char* OPS = p.ws + WS_OPS;
    const float* cw = p.in[13];
    LAS u16* Kb = (LAS u16*)(lds + PL_KB); LAS u16* Qb = (LAS u16*)(lds + PL_QB);
    LAS float* KKf = (LAS float*)(lds + PL_KK); LAS float* QKf = (LAS float*)(lds + PL_QK);
    LAS float* beta = (LAS float*)(lds + PL_GT); LAS float* gc = beta + 128; LAS float* rsq = beta + 256;
    LAS u16* KbeT = (LAS u16*)(lds + PL_KBE); LAS u16* VbT = (LAS u16*)(lds + PL_VBT);
    LAS float* Lf = (LAS float*)(lds + PL_PB); LAS u16* Tb = (LAS u16*)(lds + PL_TB);
    LAS float* Xq = (LAS float*)(lds + PL_XQ); LAS float* Xk = (LAS float*)(lds + PL_XK);
    for (int item = blockIdx.x; item < 16 * 128; item += gridDim.x) {
        const int hq = item >> 7, ch = item & 127, t0 = ch * 64;
        __syncthreads();
        if (tid < 128) {
            const int hvl = tid >> 6, hv = 2 * hq + hvl, tok = tid & 63;
            const float b = BA[(size_t)(t0 + tok) * 64 + hv], a = BA[(size_t)(t0 + tok) * 64 + 32 + hv];
            const float be = 1.f / (1.f + __expf(-b));
            const float xs = a + p.in[15][hv];
            const float sp = xs > 20.f ? xs : log1pf(__expf(xs));
            float g = -__expf(p.in[14][hv]) * sp;
#pragma unroll
            for (int o = 1; o < 64; o <<= 1) { const float t = __shfl_up(g, o); if (tok >= o) g += t; }
            beta[hvl * 64 + tok] = be; gc[hvl * 64 + tok] = g;
            if (tok == 63) *(float*)(OPS + (size_t)(hv * 128 + ch) * OPS_BLK + OP_GL) = __expf(g);
        }
        {
            const int cc = tid & 255, half = tid >> 8;
            const int col = cc < 128 ? hq * 128 + cc : 2048 + hq * 128 + (cc - 128);
            const float w0 = cw[col], w1 = cw[8192 + col], w2 = cw[2 * 8192 + col], w3 = cw[3 * 8192 + col];
            const int ts = t0 + 32 * half;
            float x0 = 0.f, x1 = 0.f, x2 = 0.f;
            if (ts >= 3) { x0 = bf2f(PQ[(size_t)(ts - 3) * 8192 + col]); x1 = bf2f(PQ[(size_t)(ts - 2) * 8192 + col]); x2 = bf2f(PQ[(size_t)(ts - 1) * 8192 + col]); }
            LAS float* X = cc < 128 ? Xq : Xk; const int c7 = cc & 127;
#pragma unroll 8
            for (int t = 0; t < 32; ++t) {
                const float x3 = bf2f(PQ[(size_t)(ts + t) * 8192 + col]);
                const float y = w0 * x0 + w1 * x1 + w2 * x2 + w3 * x3;
                X[(32 * half + t) * 129 + c7] = silu_f(y); x0 = x1; x1 = x2; x2 = x3;
            }
        }
        __syncthreads();
        if (tid < 128) {
            const int which = tid >> 6, tok = tid & 63; const LAS float* X = (which ? Xk : Xq) + tok * 129; float s = 0.f;
            for (int c = 0; c < 128; ++c) s += X[c] * X[c];
            rsq[tid] = __builtin_amdgcn_rsqf(s + EPS) * (which ? 1.f : 0.08838834764831845f);
        }
        __syncthreads();
        for (int i = tid; i < 2 * 64 * 128; i += 512) {
            const int which = i >> 13, tok = (i >> 7) & 63, c = i & 127;
            const float v = (which ? Xk : Xq)[tok * 129 + c] * rsq[which * 64 + tok];
            (which ? Kb : Qb)[tok * 136 + c] = f2bf(v);
        }
        __syncthreads();
        {
            const int ti = (wave >> 1) & 1, tj = wave & 1; v16f c = {};
            c = mm_tile(c, (wave < 4 ? Kb : Qb) + 32 * ti * 136, 136, Kb + 32 * tj * 136, 136, 128, lane);
            LAS float* D = wave < 4 ? KKf : QKf;
#pragma unroll
            for (int r = 0; r < 16; ++r) D[(32 * ti + crow(r, hi)) * 65 + 32 * tj + n] = c[r];
        }
        __syncthreads();
        for (int hvl = 0; hvl < 2; ++hvl) {
            const int hv = 2 * hq + hvl;
            const LAS float* be = beta + hvl * 64; const LAS float* g = gc + hvl * 64;
            unsigned char* ob = OPS + (size_t)(hv * 128 + ch) * OPS_BLK;
            {
                const int c = tid & 127, q4 = tid >> 7, col = 4096 + hv * 128 + c;
                const float w0 = cw[col], w1 = cw[8192 + col], w2 = cw[2 * 8192 + col], w3 = cw[3 * 8192 + col];
                const int ts = t0 + 16 * q4;
                float x0 = 0.f, x1 = 0.f, x2 = 0.f;
                if (ts >= 3) { x0 = bf2f(PQ[(size_t)(ts - 3) * 8192 + col]); x1 = bf2f(PQ[(size_t)(ts - 2) * 8192 + col]); x2 = bf2f(PQ[(size_t)(ts - 1) * 8192 + col]); }
#pragma unroll 8
                for (int t = 0; t < 16; ++t) {
                    const float x3 = bf2f(PQ[(size_t)(ts + t) * 8192 + col]);
                    const float y = w0 * x0 + w1 * x1 + w2 * x2 + w3 * x3; const int tok = 16 * q4 + t;
                    VbT[c * 72 + tok] = f2bf(be[tok] * silu_f(y)); x0 = x1; x1 = x2; x2 = x3;
                }
            }
            for (int i = tid; i < 128 * 64; i += 512) { const int d = i >> 6, tok = i & 63; KbeT[d * 72 + tok] = f2bf(bf2f(Kb[tok * 136 + d]) * be[tok] * __expf(g[tok])); }
            for (int e = tid; e < 64 * 64; e += 512) {
                const int i = e >> 6, j = e & 63;
                Lf[i * 64 + j] = j < i ? be[i] * KKf[i * 65 + j] * __expf(g[i] - g[j]) : 0.f;
            }
            __syncthreads();
            if (wave == 0) {
                float tc[64];
#pragma unroll
                for (int i = 0; i < 64; ++i) {
                    float acc = (lane == i) ? 1.f : 0.f;
#pragma unroll
                    for (int j = 0; j < i; ++j) acc -= Lf[i * 64 + j] * tc[j];
                    tc[i] = acc;
                }
#pragma unroll
                for (int i = 0; i < 64; ++i) Tb[i * 72 + lane] = f2bf(tc[i]);
            }
            __syncthreads();
            {
                const int mt = wave >> 2, nt = wave & 3; v16f c = {};
                c = mm_tile(c, Tb + 32 * mt * 72, 72, VbT + 32 * nt * 72, 72, 64, lane);
                v8s lo = pack8f(c[0], c[1], c[2], c[3], c[4], c[5], c[6], c[7]), hi8 = pack8f(c[8], c[9], c[10], c[11], c[12], c[13], c[14], c[15]);
                unsigned char* d = ob + OP_U + nt * 4096 + (mt * 64 + lane) * 32;
                *(v8s*)d = lo; *(v8s*)(d + 16) = hi8;
            }
            {
                const int t = wave >> 1, mt = wave & 1; v16f c = {};
                c = mm_tile(c, KbeT + 32 * t * 72, 72, Tb + 32 * mt * 72, 72, 64, lane);
                v8s lo = pack8f(-c[0], -c[1], -c[2], -c[3], -c[4], -c[5], -c[6], -c[7]), hi8 = pack8f(-c[8], -c[9], -c[10], -c[11], -c[12], -c[13], -c[14], -c[15]);
                *(v8s*)(ob + OP_W + (mt * 8 + 2 * t) * 1024 + lane * 16) = lo;
                *(v8s*)(ob + OP_W + (mt * 8 + 2 * t + 1) * 1024 + lane * 16) = hi8;
            }
            for (int task = tid; task < 1024; task += 512) {
                const int f = task >> 6, l = task & 63, m = l & 31, h2 = l >> 5, mi = f >> 3, ks = f & 7;
                const int tok = 32 * mi + m, d0 = 16 * ks + 4 * h2; const float eg = __expf(g[tok]);
                const LAS u16* q = Qb + tok * 136 + d0;
                *(v8s*)(ob + OP_QD + f * 1024 + l * 16) = pack8f(bf2f(q[0]) * eg, bf2f(q[1]) * eg, bf2f(q[2]) * eg, bf2f(q[3]) * eg, bf2f(q[8]) * eg, bf2f(q[9]) * eg, bf2f(q[10]) * eg, bf2f(q[11]) * eg);
            }
            {
                const float g63 = g[63];
                for (int task = tid; task < 1024; task += 512) {
                    const int f = task >> 6, l = task & 63, m = l & 31, h2 = l >> 5, t = f >> 2, ks = f & 3;
                    const int tk0 = 16 * ks + 4 * h2, d = 32 * t + m; float v[8];
#pragma unroll
                    for (int j = 0; j < 8; ++j) { const int tok = tk0 + (j & 3) + 8 * (j >> 2); v[j] = bf2f(Kb[tok * 136 + d]) * __expf(g63 - g[tok]); }
                    *(v8s*)(ob + OP_KD + f * 1024 + l * 16) = pack8f(v[0], v[1], v[2], v[3], v[4], v[5], v[6], v[7]);
                }
            }
            {
                const int f = tid >> 6, l = tid & 63, m = l & 31, h2 = l >> 5, mi = f >> 2, ks = f & 3;
                const int i = 32 * mi + m, tk0 = 16 * ks + 4 * h2; const float gi = g[i]; float v[8];
#pragma unroll
                for (int j = 0; j < 8; ++j) { const int tok = tk0 + (j & 3) + 8 * (j >> 2); v[j] = tok <= i ? QKf[i * 65 + tok] * __expf(gi - g[tok]) : 0.f; }
                *(v8s*)(ob + OP_QK + f * 1024 + l * 16) = pack8f(v[0], v[1], v[2], v[3], v[4], v[5], v[6], v[7]);
            }
            __syncthreads();
        }
    }
}

__device__ __forceinline__ void phase_gdn_scan(const Params& p, LAS unsigned char* lds) {
    if (otid() >= 64 || (blockIdx.x >> 3) >= 16) return;
    const int lane = otid(), hv = (blockIdx.x & 7) * 4 + (blockIdx.x >> 5), nt = (blockIdx.x >> 3) & 3, n = lane & 31, hi = lane >> 5;
    const unsigned char* src0 = p.ws + WS_OPS + (size_t)hv * 128 * OPS_BLK;
    float* og = (float*)(p.ws + WS_OG);
    v16f St[4];
#pragma unroll
    for (int t = 0; t < 4; ++t)
#pragma unroll
        for (int r = 0; r < 16; ++r) St[t][r] = 0.f;
#define SCAN_ISSUE(c_, buf_) do { const unsigned char* s_ = src0 + (size_t)(c_) * OPS_BLK + lane * 16; LAS unsigned char* d_ = lds + (buf_) * SCAN_BUF; \
        _Pragma("unroll") for (int i_ = 0; i_ < 56; ++i_) __builtin_amdgcn_global_load_lds((const unsigned*)(s_ + i_ * 1024), (LAS unsigned*)(d_ + i_ * 1024), 16, 0, 0); \
        _Pragma("unroll") for (int i_ = 0; i_ < 4; ++i_) __builtin_amdgcn_global_load_lds((const unsigned*)(s_ + OP_U + nt * 4096 + i_ * 1024), (LAS unsigned*)(d_ + OP_U + i_ * 1024), 16, 0, 0); } while (0)
    SCAN_ISSUE(0, 0);
    float gl_next = *(const float*)(src0 + OP_GL);
    for (int c = 0; c < 128; ++c) {
        const int buf = c & 1;
        VM_WAIT();
        if (c + 1 < 128) SCAN_ISSUE(c + 1, buf ^ 1);
        const LAS unsigned char* B = lds + buf * SCAN_BUF;
        const float gl = gl_next;
        if (c + 1 < 128) gl_next = *(const float*)(src0 + (size_t)(c + 1) * OPS_BLK + OP_GL);
        v8s Sb[8];
#pragma unroll
        for (int t = 0; t < 4; ++t) {
            Sb[2 * t] = pack8f(St[t][0], St[t][1], St[t][2], St[t][3], St[t][4], St[t][5], St[t][6], St[t][7]);
            Sb[2 * t + 1] = pack8f(St[t][8], St[t][9], St[t][10], St[t][11], St[t][12], St[t][13], St[t][14], St[t][15]);
#pragma unroll
            for (int r = 0; r < 16; ++r) St[t][r] *= gl;
        }
        v16f Vn[2], O2[2];
#pragma unroll
        for (int mt = 0; mt < 2; ++mt) {
            const v4u u0 = *(const LAS v4u*)(B + OP_U + (mt * 64 + lane) * 32), u1 = *(const LAS v4u*)(B + OP_U + (mt * 64 + lane) * 32 + 16);
            Vn[mt][0] = bflo(u0.x); Vn[mt][1] = bfhi(u0.x); Vn[mt][2] = bflo(u0.y); Vn[mt][3] = bfhi(u0.y); Vn[mt][4] = bflo(u0.z); Vn[mt][5] = bfhi(u0.z); Vn[mt][6] = bflo(u0.w); Vn[mt][7] = bfhi(u0.w);
            Vn[mt][8] = bflo(u1.x); Vn[mt][9] = bfhi(u1.x); Vn[mt][10] = bflo(u1.y); Vn[mt][11] = bfhi(u1.y); Vn[mt][12] = bflo(u1.z); Vn[mt][13] = bfhi(u1.z); Vn[mt][14] = bflo(u1.w); Vn[mt][15] = bfhi(u1.w);
#pragma unroll
            for (int r = 0; r < 16; ++r) O2[mt][r] = 0.f;
        }
#pragma unroll
        for (int ks = 0; ks < 8; ++ks)
#pragma unroll
            for (int mt = 0; mt < 2; ++mt) Vn[mt] = __builtin_amdgcn_mfma_f32_32x32x16_bf16(*(const LAS v8s*)(B + OP_W + (mt * 8 + ks) * 1024 + lane * 16), Sb[ks], Vn[mt], 0, 0, 0);
#pragma unroll
        for (int ks = 0; ks < 8; ++ks)
#pragma unroll
            for (int mi = 0; mi < 2; ++mi) O2[mi] = __builtin_amdgcn_mfma_f32_32x32x16_bf16(*(const LAS v8s*)(B + OP_QD + (mi * 8 + ks) * 1024 + lane * 16), Sb[ks], O2[mi], 0, 0, 0);
        v8s Vb[4];
#pragma unroll
        for (int mt = 0; mt < 2; ++mt) {
            Vb[2 * mt] = pack8f(Vn[mt][0], Vn[mt][1], Vn[mt][2], Vn[mt][3], Vn[mt][4], Vn[mt][5], Vn[mt][6], Vn[mt][7]);
            Vb[2 * mt + 1] = pack8f(Vn[mt][8], Vn[mt][9], Vn[mt][10], Vn[mt][11], Vn[mt][12], Vn[mt][13], Vn[mt][14], Vn[mt][15]);
        }
#pragma unroll
        for (int ks = 0; ks < 4; ++ks)
#pragma unroll
            for (int mi = 0; mi < 2; ++mi) O2[mi] = __builtin_amdgcn_mfma_f32_32x32x16_bf16(*(const LAS v8s*)(B + OP_QK + (mi * 4 + ks) * 1024 + lane * 16), Vb[ks], O2[mi], 0, 0, 0);
#pragma unroll
        for (int ks = 0; ks < 4; ++ks)
#pragma unroll
            for (int t = 0; t < 4; ++t) St[t] = __builtin_amdgcn_mfma_f32_32x32x16_bf16(*(const LAS v8s*)(B + OP_KD + (t * 4 + ks) * 1024 + lane * 16), Vb[ks], St[t], 0, 0, 0);
#pragma unroll
        for (int mi = 0; mi < 2; ++mi)
#pragma unroll
            for (int r = 0; r < 16; ++r) og[(size_t)(c * 64 + 32 * mi + crow(r, hi)) * GV + hv * 128 + nt * 32 + n] = O2[mi][r];
    }
#undef SCAN_ISSUE
}

constexpr size_t WS_SQ = 357 * MiB, WS_SK = 421 * MiB, WS_SV = 485 * MiB, WS_SG = 613 * MiB;
__device__ __forceinline__ float conv4_at(const u16* PQ, const float* cw, int t, int col) {
    float y = 0.f;
#pragma unroll
    for (int j = 0; j < 4; ++j) { const int tt = t - 3 + j; if (tt >= 0) y += cw[j * 8192 + col] * bf2f(PQ[(size_t)tt * 8192 + col]); }
    return silu_f(y);
}
__device__ __forceinline__ void phase_gdn_prep_simple(const Params& p) {
    const int tid = otid(), lane = tid & 63, wave = tid >> 6;
    const int gw = blockIdx.x * 8 + wave, NGW = gridDim.x * 8;
    const u16* PQ = (const u16*)(p.ws + WS_PQKV); const float* BA = (const float*)(p.ws + WS_BA); const float* cw = p.in[13];
    float* SQ = (float*)(p.ws + WS_SQ); float* SK = (float*)(p.ws + WS_SK); float* SV = (float*)(p.ws + WS_SV); float* SG = (float*)(p.ws + WS_SG);
    for (int it = gw; it < S_ * 16; it += NGW) {
        const int t = it >> 4, hq = it & 15;
        const int c0 = 2 * lane;
        const float q0 = conv4_at(PQ, cw, t, hq * 128 + c0), q1 = conv4_at(PQ, cw, t, hq * 128 + c0 + 1);
        const float k0 = conv4_at(PQ, cw, t, 2048 + hq * 128 + c0), k1 = conv4_at(PQ, cw, t, 2048 + hq * 128 + c0 + 1);
        const float rq = __builtin_amdgcn_rsqf(wave_sum(q0 * q0 + q1 * q1) + EPS) * 0.08838834764831845f;
        const float rk = __builtin_amdgcn_rsqf(wave_sum(k0 * k0 + k1 * k1) + EPS);
        SQ[(size_t)t * 2048 + hq * 128 + c0] = q0 * rq; SQ[(size_t)t * 2048 + hq * 128 + c0 + 1] = q1 * rq;
        SK[(size_t)t * 2048 + hq * 128 + c0] = k0 * rk; SK[(size_t)t * 2048 + hq * 128 + c0 + 1] = k1 * rk;
#pragma unroll
        for (int hvl = 0; hvl < 2; ++hvl) {
            const int hv = 2 * hq + hvl;
            const float be = 1.f / (1.f + __expf(-BA[(size_t)t * 64 + hv]));
            const float v0 = conv4_at(PQ, cw, t, 4096 + hv * 128 + c0), v1 = conv4_at(PQ, cw, t, 4096 + hv * 128 + c0 + 1);
            SV[(size_t)t * 4096 + hv * 128 + c0] = be * v0; SV[(size_t)t * 4096 + hv * 128 + c0 + 1] = be * v1;
            if (lane == 0) {
                const float xs = BA[(size_t)t * 64 + 32 + hv] + p.in[15][hv];
                const float sp = xs > 20.f ? xs : log1pf(__expf(xs));
                SG[((size_t)t * 32 + hv) * 2] = -__expf(p.in[14][hv]) * sp; SG[((size_t)t * 32 + hv) * 2 + 1] = be;
            }
        }
    }
}
__device__ __forceinline__ void phase_gdn_scan_simple(const Params& p, LAS unsigned char* lds) {
    if (blockIdx.x >= 32) return;
    const int tid = otid(), hv = blockIdx.x, hq = hv >> 1;
    const float* SQ = (const float*)(p.ws + WS_SQ); const float* SK = (const float*)(p.ws + WS_SK); const float* SV = (const float*)(p.ws + WS_SV); const float* SG = (const float*)(p.ws + WS_SG);
    float* og = (float*)(p.ws + WS_OG);
    LAS float* kq = (LAS float*)lds;
    LAS float* gb = kq + 64 * 256;
    float St[64];
#pragma unroll
    for (int d = 0; d < 64; ++d) St[d] = 0.f;
    const int e = tid >> 1, h = tid & 1;
    for (int c = 0; c < 128; ++c) {
        __syncthreads();
        for (int i = tid; i < 64 * 128; i += 512) { const int tok = i >> 7, d = i & 127; const size_t g = (size_t)(c * 64 + tok) * 2048 + hq * 128 + d;
            kq[tok * 256 + d] = SK[g]; kq[tok * 256 + 128 + d] = SQ[g]; }
        if (tid < 128) gb[tid] = SG[((size_t)(c * 64 + (tid >> 1)) * 32 + hv) * 2 + (tid & 1)];
        __syncthreads();
        if (tid < 256) {
            for (int tok = 0; tok < 64; ++tok) {
                const float dec = __expf(gb[2 * tok]), be = gb[2 * tok + 1];
                const float bv = SV[(size_t)(c * 64 + tok) * 4096 + hv * 128 + e];
                const LAS float* kk = kq + tok * 256 + 64 * h; const LAS float* qq = kk + 128;
                float ks = 0.f;
#pragma unroll
                for (int d = 0; d < 64; ++d) ks += kk[d] * St[d];
                ks += __shfl_xor(ks, 1);
                const float delta = bv - be * dec * ks;
                float o = 0.f;
#pragma unroll
                for (int d = 0; d < 64; ++d) { St[d] = dec * St[d] + kk[d] * delta; o += qq[d] * St[d]; }
                o += __shfl_xor(o, 1);
                if (h == 0) og[(size_t)(c * 64 + tok) * GV + hv * 128 + e] = o;
            }
        }
    }
}
__device__ __forceinline__ void phase_gdn_post(const Params& p) {
    const int tid = otid(), lane = tid & 63, wave = tid >> 6;
    const int gw = blockIdx.x * 8 + wave, NGW = gridDim.x * 8;
    const float* og = (const float*)(p.ws + WS_OG); const u16* Z = (const u16*)(p.ws + WS_Z); u16* out = (u16*)(p.ws + WS_OGN);
    const int e0 = 4 * (lane & 31); const v4f gn = *(const v4f*)(p.in[16] + e0);
    for (int it = gw; it < S_ * 16; it += NGW) {
        const int t = it >> 4, hv = 2 * (it & 15) + (lane >> 5);
        const size_t off = (size_t)t * GV + hv * 128 + e0;
        const v4f ow = *(const v4f*)(og + off); const v2u zw = *(const v2u*)(Z + off);
        float o0 = ow[0], o1 = ow[1], o2 = ow[2], o3 = ow[3];
        if (!(__builtin_fabsf(o0) < 1e30f)) o0 = 0.f; if (!(__builtin_fabsf(o1) < 1e30f)) o1 = 0.f; if (!(__builtin_fabsf(o2) < 1e30f)) o2 = 0.f; if (!(__builtin_fabsf(o3) < 1e30f)) o3 = 0.f;
        float ss = (o0 * o0 + o1 * o1) + (o2 * o2 + o3 * o3);
#pragma unroll
        for (int o = 1; o < 32; o <<= 1) ss += __shfl_xor(ss, o);
        const float rs = __builtin_amdgcn_rsqf(ss * (1.f / 128.f) + EPS);
        v2u w; w.x = cvtpk(o0 * rs * gn[0] * silu_f(bflo(zw.x)), o1 * rs * gn[1] * silu_f(bfhi(zw.x)));
        w.y = cvtpk(o2 * rs * gn[2] * silu_f(bflo(zw.y)), o3 * rs * gn[3] * silu_f(bfhi(zw.y)));
        *(v2u*)(out + off) = w;
    }
}

constexpr int NPHASE = 16;
template <int ph> __device__ __forceinline__ void run_phase(const Params& p, LAS unsigned char* lds, unsigned char* lds_raw) {
    unsigned char* ws = p.ws;
    float* ssq = (float*)(ws + WS_SSQ);
    u16* XB = (u16*)(ws + WS_XB);
    const int G = gridDim.x, c = blockIdx.x;
    switch (ph) {
    case 0: phase_p0(p, lds); break;
    case 1: { pg8::Gemm g{XB, (const u16*)(ws + WS_WQKV), S_, NQKV, DM}; pg8::StaticOrder S; S.init(S_, NQKV, G, c);
              EpiQKV E{(u16*)(ws + WS_QH)};
              pg8::gemm_phase<EpiQKV, pg8::StaticOrder>(lds, g, S, E, nullptr); } break;
    case 2: phase_attn(p, (char*)lds_raw); break;
    case 3: phase_combine(p); break;
    case 4: { pg8::Gemm g{(const u16*)(ws + WS_OB), (const u16*)(ws + WS_WO), S_, DM, DM}; pg8::StaticOrder S; S.init(S_, DM, G, c);
              EpiRes E{p.in[0], p.out, XB, ssq}; pg8::gemm_phase<EpiRes, pg8::StaticOrder>(lds, g, S, E, nullptr); } break;
    case 5: case 13: { const int l = ph == 13; pg8::Gemm g{XB, (const u16*)(ws + (l ? WS_WUP1 : WS_WUP0)), S_, NUP, DM}; pg8::StaticOrder S; S.init(S_, NUP, G, c);
              EpiScale E{ssq + (l ? 64 * S_ : 0), (u16*)(ws + WS_U), NUP, NUP, nullptr, 0, NUP, nullptr, 0, NUP};
              pg8::gemm_phase<EpiScale, pg8::StaticOrder>(lds, g, S, E, nullptr); } break;
    case 6: case 14: phase_convgate(p, ph == 14); break;
    case 7: case 15: { const int l = ph == 15; pg8::Gemm g{(const u16*)(ws + WS_Y), (const u16*)(ws + (l ? WS_WDN1 : WS_WDN0)), S_, DM, DFF}; pg8::StaticOrder S; S.init(S_, DM, G, c);
              EpiRes E{p.out, p.out, l ? nullptr : XB, l ? nullptr : ssq + 32 * S_}; pg8::gemm_phase<EpiRes, pg8::StaticOrder>(lds, g, S, E, nullptr); } break;
    case 8: { pg8::Gemm g{XB, (const u16*)(ws + WS_WIN), S_, GINP, DM}; pg8::StaticOrder S; S.init(S_, GINP, G, c);
              EpiScale E{ssq + 32 * S_, (u16*)(ws + WS_PQKV), 8192, 8192, (u16*)(ws + WS_Z), GV, 12288, (float*)(ws + WS_BA), 64, GIN};
              pg8::gemm_phase<EpiScale, pg8::StaticOrder>(lds, g, S, E, nullptr); } break;
#if MK_GDN_SIMPLE
    case 9: phase_gdn_prep_simple(p); break;
    case 10: phase_gdn_scan_simple(p, lds); break;
#else
    case 9: phase_gdn_prep(p, lds); break;
    case 10: phase_gdn_scan(p, lds); break;
#endif
    case 11: phase_gdn_post(p); break;
    case 12: { pg8::Gemm g{(const u16*)(ws + WS_OGN), (const u16*)(ws + WS_WOUT), S_, DM, GV}; pg8::StaticOrder S; S.init(S_, DM, G, c);
              EpiRes E{p.out, p.out, XB, ssq + 64 * S_}; pg8::gemm_phase<EpiRes, pg8::StaticOrder>(lds, g, S, E, nullptr); } break;
    default: break;
    }
}
#ifdef MK_TEST_PHASES
template <int PH> __global__ void __launch_bounds__(512, 2) t_ph(Params p) {
    extern __shared__ __attribute__((aligned(16))) unsigned char lds_raw[];
    run_phase<PH>(p, (LAS unsigned char*)lds_raw, lds_raw);
}
template __global__ void t_ph<0>(Params); template __global__ void t_ph<1>(Params); template __global__ void t_ph<2>(Params); template __global__ void t_ph<3>(Params);
template __global__ void t_ph<4>(Params); template __global__ void t_ph<5>(Params); template __global__ void t_ph<6>(Params); template __global__ void t_ph<7>(Params);
template __global__ void t_ph<8>(Params); template __global__ void t_ph<9>(Params); template __global__ void t_ph<10>(Params); template __global__ void t_ph<11>(Params);
template __global__ void t_ph<12>(Params);
#endif
__global__ void __launch_bounds__(512, 2) mk_fwd(Params p) {
    extern __shared__ __attribute__((aligned(16))) unsigned char lds_raw[];
    LAS unsigned char* lds = (LAS unsigned char*)lds_raw;
    cg::grid_group grid = cg::this_grid();
    const int lo = p.ph_lo, hi = p.ph_hi;
#define PHASE(k) if (lo <= (k) && (k) < hi) { run_phase<k>(p, lds, lds_raw); if ((k) + 1 < hi) grid.sync(); }
    PHASE(0) PHASE(1)
    if (lo <= 2 && 2 < hi) { phase_qknorm(p); grid.sync(); }
    PHASE(2) PHASE(3) PHASE(4) PHASE(5) PHASE(6) PHASE(7) PHASE(8) PHASE(9) PHASE(10) PHASE(11) PHASE(12) PHASE(13) PHASE(14) PHASE(15)
#undef PHASE
#ifdef MK_DUMP_OFF
    grid.sync();
    { const u16* src = (const u16*)(p.ws + (size_t)MK_DUMP_OFF); const size_t gt = (size_t)blockIdx.x * 512 + otid(), NT = (size_t)gridDim.x * 512;
      for (size_t i = gt; i < (size_t)S_ * DM; i += NT) {
          const int cat = (int)(i / 3355443), j = (int)(i % 3355443); if (cat > 4) { p.out[i] = 0.f; continue; }
          const int blk = j & 4095, e = (j >> 12) & 4095;
          const int opx = cat == 0 ? OP_QD : cat == 1 ? OP_KD : cat == 2 ? OP_QK : cat == 3 ? OP_W : OP_U;
          const float wgt = cat == 0 ? 1e6f : cat == 1 ? 1e5f : cat == 2 ? 1e4f : cat == 3 ? 1e3f : 1e2f;
          const float v = bf2f(src[(size_t)blk * (OPS_BLK / 2) + opx / 2 + e * 4]);
          p.out[i] = !(__builtin_fabsf(v) < 50.f) ? wgt : 0.f; } }
#endif
}

#ifndef MK_PH_HI
#endif
extern "C" void kernel_launch(void* const* d_in, const int* in_sizes, int n_in, void* d_out, int out_size, void* d_ws, size_t ws_size, hipStream_t stream) {
    static int grid = 0;
    if (grid == 0) {
        if (n_in != 22 || out_size != S_ * DM || ws_size < WS_END) { fprintf(stderr, "kernel_launch: unexpected shapes (n_in %d out %d ws %zu)\n", n_in, out_size, ws_size); grid = -1; return; }
        int dev = 0, cus = 0, per_cu = 0;
        (void)hipGetDevice(&dev); (void)hipDeviceGetAttribute(&cus, hipDeviceAttributeMultiprocessorCount, dev);
        if (hipFuncSetAttribute((const void*)mk_fwd, hipFuncAttributeMaxDynamicSharedMemorySize, LDS_BYTES) != hipSuccess) { fprintf(stderr, "kernel_launch: hipFuncSetAttribute failed\n"); grid = -1; return; }
        if (hipOccupancyMaxActiveBlocksPerMultiprocessor(&per_cu, (const void*)mk_fwd, 512, LDS_BYTES) != hipSuccess || per_cu < 1) { fprintf(stderr, "kernel_launch: occupancy query says %d\n", per_cu); per_cu = 1; }
        (void)hipGetLastError();
        if (cus <= 0) cus = 256;
        grid = cus;
    }
    if (grid < 0) return;
    Params p{};
    for (int i = 0; i < 22; ++i) p.in[i] = (const float*)d_in[i];
    p.out = (float*)d_out; p.ws = (unsigned char*)d_ws;
#if MK_PER_PHASE
    for (int ph = 0; ph < NPHASE; ++ph) { p.ph_lo = ph; p.ph_hi = ph + 1; void* args[] = {&p};
        hipError_t e = hipLaunchCooperativeKernel((const void*)mk_fwd, dim3(grid), dim3(512), args, LDS_BYTES, stream);
        if (e != hipSuccess) { fprintf(stderr, "launch %d failed: %s\n", ph, hipGetErrorString(e)); break; } }
#else
    p.ph_lo = 0; p.ph_hi = MK_PH_HI; void* args[] = {&p};
    hipError_t e = hipLaunchCooperativeKernel((const void*)mk_fwd, dim3(grid), dim3(512), args, LDS_BYTES, stream);
    if (e != hipSuccess) fprintf(stderr, "cooperative launch failed: %s (grid %d)\n", hipGetErrorString(e), grid);
#endif
}
```

```cpp
#include <hip/hip_runtime.h>
#include <hip/hip_bf16.h>
#include <hip/hip_cooperative_groups.h>
#include <cstdio>
#include <cstdint>
namespace cg = cooperative_groups;
__device__ __forceinline__ int otid() { int t = (int)__builtin_amdgcn_workitem_id_x(); asm volatile("" : "+v"(t)); return t; }
#include <hip/hip_runtime.h>
namespace pg8 {
#define PG8_LAS __attribute__((address_space(3)))
typedef unsigned short bf16_t;
typedef short bf16x8 __attribute__((ext_vector_type(8)));
typedef float f32x4 __attribute__((ext_vector_type(4)));
typedef unsigned u32x4 __attribute__((ext_vector_type(4)));
constexpr int BM = 256, BK = 64, HALF = 128, HTB = HALF * BK * 2  , STAGE_BYTES = 8 * HTB, NXCD = 8, WGM = 8;

__host__ __device__ __forceinline__ int lds_byte(int r, int c) { const int st = (r >> 4) * 2 + (c >> 5), rr = r & 15, cc = c & 31, ob = rr * 64 + cc * 2; return st * 1024 + (ob ^ (((ob >> 9) & 1) << 5)); }
__host__ __device__ __forceinline__ void stage_rc(int b, int& R, int& C) { const int st = b / 1024, sb = b % 1024, swz = sb ^ (((sb >> 9) & 1) << 5); R = (st >> 1) * 16 + swz / 64; C = (st & 1) * 32 + (swz % 64) / 2; }
__host__ __device__ __forceinline__ int perm32(int rho) { const int n = rho >> 4, i = rho & 15; return 8 * (i >> 2) + 4 * n + (i & 3); }

struct Unit { int pm, pn; };
struct Gemm { const bf16_t* A; const bf16_t* Bt; int M, N, K; };

struct StaticOrder {
    int nM, nN, nwg, G, c;
    __host__ __device__ void init(int M, int N, int G_, int c_) { nM = M / BM; nN = N / BM; nwg = nM * nN; G = G_; c = c_; }
    __host__ __device__ bool next(int i, Unit& u) const {
        const long L = (long)i * G + c; if (L >= nwg) return false;
        int wgid = (int)L; { const int q = nwg / NXCD, r = nwg % NXCD, xcd = wgid % NXCD, off = wgid / NXCD; wgid = (xcd < r ? xcd * (q + 1) : r * (q + 1) + (xcd - r) * q) + off; }
        const int nig = WGM * nN, gid = wgid / nig, fm = gid * WGM, gsz = (nM - fm) < WGM ? (nM - fm) : WGM;
        u.pm = fm + ((wgid % nig) % gsz); u.pn = (wgid % nig) / gsz; return true;
    }
    __device__ __forceinline__ void a_ready(const Unit&) const {}
    __device__ __forceinline__ void done(const Unit&) const {}
};
struct CountedOrder : StaticOrder {
    const unsigned* ready; unsigned need; unsigned* tmo;
    __device__ __forceinline__ void a_ready(const Unit& u) const {
        if (otid() < 64) {
            const unsigned long long t0 = __builtin_amdgcn_s_memrealtime(); unsigned polls = 0;
            while ((unsigned)__builtin_amdgcn_readfirstlane(__hip_atomic_load(ready + 64 * u.pm, __ATOMIC_RELAXED, __HIP_MEMORY_SCOPE_AGENT)) < need) {
                if ((++polls & 255u) == 0u && __builtin_amdgcn_readfirstlane(__hip_atomic_load(tmo, __ATOMIC_RELAXED, __HIP_MEMORY_SCOPE_AGENT)) != 0u) break;
                if (__builtin_amdgcn_s_memrealtime() - t0 > 2000000ull) {
                    if (otid() == 0) { unsigned expect = 0u; __hip_atomic_compare_exchange_strong(tmo + 1, &expect, 0x600u | (unsigned)(u.pm & 0xff), __ATOMIC_RELAXED, __ATOMIC_RELAXED, __HIP_MEMORY_SCOPE_AGENT); __hip_atomic_store(tmo, 1u, __ATOMIC_RELAXED, __HIP_MEMORY_SCOPE_AGENT); }
                    break; }
                __builtin_amdgcn_s_sleep(2); }
            __builtin_amdgcn_fence(__ATOMIC_ACQUIRE, "agent");
            asm volatile("s_waitcnt vmcnt(0)" ::: "memory");
        }
#if !defined(BROKEN_HOOK_NO_BARRIER)
        asm volatile("" ::: "memory"); __builtin_amdgcn_s_barrier(); asm volatile("" ::: "memory");
#endif
    }
};

template <class Epi, class Sched, bool STAMP = false>
__device__ __forceinline__ void gemm_phase(PG8_LAS unsigned char* lds, const Gemm g, const Sched& S, const Epi& E, unsigned long long* stamps) {
    const int tid = otid(), wid = __builtin_amdgcn_readfirstlane(tid >> 6), lane = tid & 63, wr = wid >> 2, wc = wid & 3, fr = lane & 15, fq = lane >> 4;
    const int K = g.K, nt = K / BK;
    int ts_lo = 0, ts_hi = 0, nts = 0; const unsigned long long rt_entry = STAMP ? (unsigned long long)wall_clock64() : 0ull;
#define PG8_STAMP() do { if (STAMP && wid == 0 && nts < 64) { const unsigned long long _c = (unsigned long long)clock64(); \
        ts_lo = (lane == nts) ? (int)(unsigned)_c : ts_lo; ts_hi = (lane == nts) ? (int)(unsigned)(_c >> 32) : ts_hi; ++nts; } } while (0)
    PG8_STAMP();
    unsigned voffA[2], voffB[2];
#pragma unroll
    for (int i = 0; i < 2; ++i) { int R, C; stage_rc(tid * 16 + i * 8192, R, C); const int Rb = Epi::PERM ? ((R & ~31) + perm32(R & 31)) : R;
        voffA[i] = (unsigned)(R * K + C) * 2u; voffB[i] = (unsigned)(Rb * K + C) * 2u; }
    const size_t kstep = (size_t)(BK * 2);
    const size_t hstep = (size_t)HALF * K * 2;
    const size_t tstep = 2 * hstep;
    const unsigned ldsw = (unsigned)wid * 1024u;
    const int aoff = lds_byte(wr * 64 + fr, fq * 8), boff = lds_byte(wc * 32 + fr, fq * 8);
#define PG8_SA(b, h) (((b) * 2 + (h)) * HTB)
#define PG8_SB(b, h) ((4 + (b) * 2 + (h)) * HTB)
#define PG8_STAGE(bufoff, gbase, voff) do { _Pragma("unroll") for (int _i = 0; _i < 2; ++_i) \
        __builtin_amdgcn_global_load_lds((const unsigned*)((const char*)(gbase) + (voff)[_i]), (PG8_LAS unsigned*)(lds + (bufoff) + ldsw + _i * 8192), 16, 0, 0); } while (0)
#define PG8_LDA(dst, b, h) do { _Pragma("unroll") for (int m = 0; m < 4; ++m) _Pragma("unroll") for (int k = 0; k < 2; ++k) dst[m][k] = *(const PG8_LAS bf16x8*)(lds + PG8_SA(b, h) + aoff + m * 2048 + k * 1024); } while (0)
#define PG8_LDB(dst, b, h) do { _Pragma("unroll") for (int n = 0; n < 2; ++n) _Pragma("unroll") for (int k = 0; k < 2; ++k) dst[n][k] = *(const PG8_LAS bf16x8*)(lds + PG8_SB(b, h) + boff + n * 2048 + k * 1024); } while (0)
#define PG8_MMA(ai, bj, At, Bt) do { __builtin_amdgcn_s_setprio(1); _Pragma("unroll") for (int m = 0; m < 4; ++m) _Pragma("unroll") for (int n = 0; n < 2; ++n) _Pragma("unroll") for (int k = 0; k < 2; ++k) \
        acc[ai][bj][m][n] = __builtin_amdgcn_mfma_f32_16x16x32_bf16(Bt[n][k], At[m][k], acc[ai][bj][m][n], 0, 0, 0); __builtin_amdgcn_s_setprio(0); } while (0)
#define PG8_WAIT_V(n) asm volatile("s_waitcnt vmcnt(" #n ")" ::: "memory")
#define PG8_WAIT_L(n) asm volatile("s_waitcnt lgkmcnt(" #n ")" ::: "memory")
#define PG8_BAR __builtin_amdgcn_s_barrier()
#define PG8_SCHED __builtin_amdgcn_sched_barrier(0)
    Unit cur, nxt; int ui = 0;
    if (!S.next(0, cur)) return;
    f32x4 acc[2][2][4][2];
#pragma unroll
    for (int a = 0; a < 2; ++a)
#pragma unroll
        for (int b = 0; b < 2; ++b)
#pragma unroll
            for (int m = 0; m < 4; ++m)
#pragma unroll
                for (int n = 0; n < 2; ++n) acc[a][b][m][n] = (f32x4){0.f, 0.f, 0.f, 0.f};
    bf16x8 At[4][2], B0[2][2], B1[2][2];
    const char* cA = (const char*)g.A + (size_t)cur.pm * tstep; const char* cB = (const char*)g.Bt + (size_t)cur.pn * tstep;
    S.a_ready(cur);
    PG8_STAGE(PG8_SB(0, 0), cB, voffB); PG8_STAGE(PG8_SA(0, 0), cA, voffA); PG8_STAGE(PG8_SB(0, 1), cB + hstep, voffB); PG8_STAGE(PG8_SA(0, 1), cA + hstep, voffA);
    if (wr == 1) PG8_BAR;
    PG8_WAIT_V(4); PG8_BAR;
    PG8_STAGE(PG8_SB(1, 0), cB + kstep, voffB); PG8_STAGE(PG8_SA(1, 0), cA + kstep, voffA); PG8_STAGE(PG8_SB(1, 1), cB + hstep + kstep, voffB);
    PG8_WAIT_V(6); PG8_BAR;
    PG8_STAMP();
    for (;;) {
        const bool has_next = S.next(ui + 1, nxt);
        const char* nA = has_next ? (const char*)g.A + (size_t)nxt.pm * tstep : cA; const char* nB = has_next ? (const char*)g.Bt + (size_t)nxt.pn * tstep : cB;
        for (int t = 0; t < nt; t += 2) {
            const bool last = (t == nt - 2);
            const char* a1 = cA + (size_t)(t + 1) * kstep;
            const char* a2 = last ? nA : cA + (size_t)(t + 2) * kstep; const char* b2 = last ? nB : cB + (size_t)(t + 2) * kstep;
            const char* a3 = a2 + kstep; const char* b3 = b2 + kstep;
            if (last && has_next) S.a_ready(nxt);
            PG8_LDB(B0, 0, 0); PG8_SCHED; PG8_LDA(At, 0, 0); PG8_STAGE(PG8_SA(1, 1), a1 + hstep, voffA);
            PG8_WAIT_L(8); PG8_BAR; PG8_WAIT_L(0); PG8_MMA(0, 0, At, B0); PG8_BAR; PG8_SCHED;
            PG8_LDB(B1, 0, 1); PG8_STAGE(PG8_SB(0, 0), b2, voffB);
            PG8_BAR; PG8_WAIT_L(0); PG8_MMA(0, 1, At, B1); PG8_BAR;
            PG8_LDA(At, 0, 1); PG8_STAGE(PG8_SA(0, 0), a2, voffA);
            PG8_BAR; PG8_WAIT_L(0); PG8_MMA(1, 0, At, B0); PG8_BAR; PG8_SCHED;
            PG8_STAGE(PG8_SB(0, 1), b2 + hstep, voffB);
            PG8_WAIT_V(6); PG8_BAR; PG8_MMA(1, 1, At, B1); PG8_BAR;
            PG8_LDB(B0, 1, 0); PG8_SCHED; PG8_LDA(At, 1, 0); PG8_STAGE(PG8_SA(0, 1), a2 + hstep, voffA);
            PG8_WAIT_L(8); PG8_BAR; PG8_WAIT_L(0); PG8_MMA(0, 0, At, B0); PG8_BAR; PG8_SCHED;
            PG8_LDB(B1, 1, 1); PG8_STAGE(PG8_SB(1, 0), b3, voffB);
            PG8_BAR; PG8_WAIT_L(0); PG8_MMA(0, 1, At, B1); PG8_BAR;
            PG8_LDA(At, 1, 1); PG8_STAGE(PG8_SA(1, 0), a3, voffA);
            PG8_BAR; PG8_WAIT_L(0); PG8_MMA(1, 0, At, B0); PG8_BAR; PG8_SCHED;
            PG8_STAGE(PG8_SB(1, 1), b3 + hstep, voffB);
            PG8_WAIT_V(6); PG8_BAR; PG8_MMA(1, 1, At, B1); PG8_BAR;
        }
        PG8_STAMP();
        if constexpr (!Epi::AFTER_DRAIN) { E(acc, cur, wr, wc, fr, fq); S.done(cur); }
        PG8_STAMP();
        if (!has_next) break;
#pragma unroll
        for (int a = 0; a < 2; ++a)
#pragma unroll
            for (int b = 0; b < 2; ++b)
#pragma unroll
                for (int m = 0; m < 4; ++m)
#pragma unroll
                    for (int n = 0; n < 2; ++n) acc[a][b][m][n] = (f32x4){0.f, 0.f, 0.f, 0.f};
        cur = nxt; cA = nA; cB = nB; ++ui;
    }
    PG8_WAIT_V(0);
    if (wr == 0) PG8_BAR;
    PG8_BAR;
    if constexpr (Epi::AFTER_DRAIN) { E.fused(acc, cur, wr, wc, fr, fq, lds, wid, lane); S.done(cur); }
    PG8_STAMP();
    if (STAMP && wid == 0) { stamps[lane] = lane < nts ? (((unsigned long long)(unsigned)ts_hi << 32) | (unsigned)ts_lo) : 0ull;
        if (lane == 62) stamps[62] = rt_entry; if (lane == 63) stamps[63] = (unsigned long long)wall_clock64(); }
#undef PG8_STAMP
#undef PG8_SA
#undef PG8_SB
#undef PG8_STAGE
#undef PG8_LDA
#undef PG8_LDB
#undef PG8_MMA
#undef PG8_WAIT_V
#undef PG8_WAIT_L
#undef PG8_BAR
#undef PG8_SCHED
}
}
namespace att {
constexpr int D = 128;
constexpr float SCALE = 0.08838834764831845f;
constexpr int NW = 8, QBLK = 32, KVBLK = 64, QB = NW * QBLK;
constexpr int SHM_V = KVBLK * D * 2, SHM_K = KVBLK * D * 2;
constexpr int LDS_BYTES = 2 * SHM_V + 2 * SHM_K + NW * 64 * 4;
constexpr float THR = 8.f; constexpr bool WSKIP = false;

using bf16 = __hip_bfloat16;
typedef short bf16x8 __attribute__((ext_vector_type(8)));
typedef short s16x4 __attribute__((ext_vector_type(4)));
typedef float f32x16 __attribute__((ext_vector_type(16)));
typedef float f32x4 __attribute__((ext_vector_type(4)));
typedef unsigned u32x4 __attribute__((ext_vector_type(4)));
template <class A, class Bt> struct same_t { static constexpr bool v = false; };
template <class A> struct same_t<A, A> { static constexpr bool v = true; };

#define KSWZ(row, colB) ((row) * 256 + ((colB) ^ (((row) & 7) << 4)))
#define SBAR() __builtin_amdgcn_sched_barrier(0)
__device__ __forceinline__ int v_st(int k, int c) { const int kk = (k & ~0xC) | ((k & 4) << 1) | ((k & 8) >> 1); return ((kk >> 3) * 4 + (c >> 5)) * 512 + ((kk & 7) * 32 + (c & 31)) * 2; }
__device__ __forceinline__ int v_rd_base(int lane) { return ((lane & 3) << 3) | (((lane >> 2) & 3) << 6) | (((lane >> 4) & 1) << 5) | (((lane >> 5) & 1) << 8); }
constexpr int v_rd_off(int d0, int ks, int half) { return d0 * 512 + ks * 4096 + half * 2048; }
__device__ __forceinline__ int crow(int r, int hi) { return (r & 3) + 8 * (r >> 2) + 4 * hi; }
__device__ __forceinline__ unsigned cvtpk(float lo, float hi) {
    unsigned r; asm volatile("v_cvt_pk_bf16_f32 %0, %1, %2" : "=v"(r) : "v"(lo), "v"(hi)); return r;
}
__device__ __forceinline__ bf16x8 pack8(f32x4 a, f32x4 b) {
    u32x4 w = {cvtpk(a[0], a[1]), cvtpk(a[2], a[3]), cvtpk(b[0], b[1]), cvtpk(b[2], b[3])};
    return *reinterpret_cast<bf16x8*>(&w);
}
template <class T> __device__ __forceinline__ bf16x8 load8(const T* p) {
    if constexpr (same_t<T, float>::v) { return pack8(*(const f32x4*)p, *(const f32x4*)(p + 4)); }
    else { return *reinterpret_cast<const bf16x8*>(p); }
}
__device__ __forceinline__ void mask_tile(f32x16& p0, f32x16& p1, int dq, unsigned W) {
    const float NEG = -__builtin_inff();
#pragma unroll
    for (int r = 0; r < 16; ++r) {
        const int c = (r & 3) + 8 * (r >> 2);
        if ((unsigned)(dq - c) >= W) p0[r] = NEG;
        if ((unsigned)(dq - c - 32) >= W) p1[r] = NEG;
    }
}
__device__ __forceinline__ void partialSM(f32x16& p0, f32x16& p1, float& m_reg, float& mn, float& alpha) {
    float pmax = p0[0]; for (int r = 1; r < 16; ++r) pmax = fmaxf(pmax, p0[r]); for (int r = 0; r < 16; ++r) pmax = fmaxf(pmax, p1[r]);
    { auto rr = __builtin_amdgcn_permlane32_swap(__float_as_uint(pmax), __float_as_uint(pmax), false, false);
      pmax = fmaxf(__uint_as_float(rr[0]), __uint_as_float(rr[1])); }
    constexpr float THR2 = THR * 1.4426950408889634f;
    if (__builtin_expect(__all(pmax <= THR2), 1)) { alpha = 1.f; }
    else { const float d = fmaxf(pmax, 0.f); alpha = __builtin_amdgcn_exp2f(-d); m_reg += d;
           for (int r = 0; r < 16; ++r) p0[r] -= d; for (int r = 0; r < 16; ++r) p1[r] -= d; }
    mn = m_reg;
    for (int r = 0; r < 16; ++r) p0[r] = __builtin_amdgcn_exp2f(p0[r]);
}
__device__ __forceinline__ void finishSM(f32x16& p0, f32x16& p1, float alpha, float& l_reg, bf16x8& pa0, bf16x8& pa1, bf16x8& pa2, bf16x8& pa3) {
    for (int r = 0; r < 16; ++r) p1[r] = __builtin_amdgcn_exp2f(p1[r]);
    float ps = 0; for (int r = 0; r < 16; ++r) ps += p0[r]; for (int r = 0; r < 16; ++r) ps += p1[r];
    { auto rr = __builtin_amdgcn_permlane32_swap(__float_as_uint(ps), __float_as_uint(ps), false, false);
      ps = __uint_as_float(rr[0]) + __uint_as_float(rr[1]); }
    l_reg = l_reg * alpha + ps;
#define PK4(P, B_, OUT) do { unsigned a0 = cvtpk(P[B_+0], P[B_+1]), a1 = cvtpk(P[B_+2], P[B_+3]);                          \
        unsigned b0 = cvtpk(P[B_+4], P[B_+5]), b1 = cvtpk(P[B_+6], P[B_+7]);                                             \
        auto r0 = __builtin_amdgcn_permlane32_swap(a0, b0, false, false); auto r1 = __builtin_amdgcn_permlane32_swap(a1, b1, false, false); \
        u32x4 w = {r0[0], r1[0], r0[1], r1[1]}; OUT = *reinterpret_cast<bf16x8*>(&w); } while (0)
    PK4(p0, 0, pa0); PK4(p0, 8, pa1); PK4(p1, 0, pa2); PK4(p1, 8, pa3);
#undef PK4
}
template <int KB, bool SK>
__device__ __forceinline__ void qkt(f32x16& p0, f32x16& p1, const char* K_lds, int r32, int hi, const bf16x8* qr, bool act, float nsl, float dqf, bool lin, float mreg) {
    if (SK && !act) { const float NEG = -__builtin_inff();
#pragma unroll
        for (int r = 0; r < 16; ++r) { p0[r] = NEG; p1[r] = NEG; } return; }
    {
        const float nn = -nsl;
        if (lin) {
            const float base = __builtin_fmaf(nsl, dqf, -mreg);
#pragma unroll
            for (int r = 0; r < 16; ++r) { const float c = (float)((r & 3) + 8 * (r >> 2)); p0[r] = __builtin_fmaf(nn, c, base); p1[r] = __builtin_fmaf(nn, c + 32.f, base); }
        } else {
            const float base = nsl * dqf;
#pragma unroll
            for (int r = 0; r < 16; ++r) { const float c = (float)((r & 3) + 8 * (r >> 2));
                p0[r] = __uint_as_float(__float_as_uint(__builtin_fmaf(nn, c, base)) | 0x80000000u) - mreg; p1[r] = __uint_as_float(__float_as_uint(__builtin_fmaf(nn, c + 32.f, base)) | 0x80000000u) - mreg; }
        }
    }
    const char* kb[4];
#pragma unroll
    for (int dd = 0; dd < 4; ++dd) kb[dd] = K_lds + KB * SHM_K + KSWZ(r32, (dd * 16 + hi * 8) * 2);
#pragma unroll
    for (int d0 = 0; d0 < 8; ++d0) { const char* a = kb[d0 & 3] + (d0 >> 2) * 128;
        bf16x8 b0 = *reinterpret_cast<const bf16x8*>(a);
        bf16x8 b1 = *reinterpret_cast<const bf16x8*>(a + 32 * 256);
        p0 = __builtin_amdgcn_mfma_f32_32x32x16_bf16(b0, qr[d0], p0, 0, 0, 0);
        p1 = __builtin_amdgcn_mfma_f32_32x32x16_bf16(b1, qr[d0], p1, 0, 0, 0); }
}
template <int VB, bool SK>
__device__ __forceinline__ void pv_tile(f32x16* o, int vb0, bf16x8 pa0, bf16x8 pa1, bf16x8 pa2, bf16x8 pa3, bool act) {
    if (SK && !act) return;
#define TRRD(dst, off) asm volatile("ds_read_b64_tr_b16 %0, %1 offset:%2" : "=&v"(dst) : "v"(vb0), "i"(off) : "memory")
#define PV_D0(d0) do { s16x4 l0, l1, l2, l3, h0, h1, h2, h3; constexpr int b_ = VB * SHM_V + v_rd_off(d0, 0, 0);     \
        TRRD(l0, b_); TRRD(h0, b_ + 2048); TRRD(l1, b_ + 4096); TRRD(h1, b_ + 6144); TRRD(l2, b_ + 8192); TRRD(h2, b_ + 10240); TRRD(l3, b_ + 12288); TRRD(h3, b_ + 14336); \
        asm volatile("s_waitcnt lgkmcnt(0)" ::: "memory"); SBAR();                 \
        o[d0] = __builtin_amdgcn_mfma_f32_32x32x16_bf16(pa0, (bf16x8){l0[0], l0[1], l0[2], l0[3], h0[0], h0[1], h0[2], h0[3]}, o[d0], 0, 0, 0);   \
        o[d0] = __builtin_amdgcn_mfma_f32_32x32x16_bf16(pa1, (bf16x8){l1[0], l1[1], l1[2], l1[3], h1[0], h1[1], h1[2], h1[3]}, o[d0], 0, 0, 0);   \
        o[d0] = __builtin_amdgcn_mfma_f32_32x32x16_bf16(pa2, (bf16x8){l2[0], l2[1], l2[2], l2[3], h2[0], h2[1], h2[2], h2[3]}, o[d0], 0, 0, 0);   \
        o[d0] = __builtin_amdgcn_mfma_f32_32x32x16_bf16(pa3, (bf16x8){l3[0], l3[1], l3[2], l3[3], h3[0], h3[1], h3[2], h3[3]}, o[d0], 0, 0, 0); } while (0)
    PV_D0(0); PV_D0(1); PV_D0(2); PV_D0(3);
#undef PV_D0
#undef TRRD
}

template <class TIn, class TOut> struct BlockRef { const TIn* Q; const TIn* K; const TIn* V; TOut* O; int P0; int W; float nsl; };
template <class TIn> struct Seam {
    bf16x8 qr[8];
    bf16x8 st_v0, st_v1, st_k0, st_k1; f32x4 sf0, sf1, sf2, sf3;
    f32x4 tq[16];
};
__device__ __forceinline__ int swa_jlo(int P0, int W) { const int lowk = P0 - W + 1; return lowk > 0 ? lowk / KVBLK : 0; }
#define ROW(p, k0, rr) ((p) + (size_t)((k0) + (rr)) * D + sc)
#define VMW() asm volatile("s_waitcnt vmcnt(0)" ::: "memory")
#define VMWN(n) asm volatile("s_waitcnt vmcnt(%0)" :: "i"(n) : "memory")
#define SLOAD_H(Kp, Vp, k0) do { S.st_v0 = load8<TIn>(ROW(Vp, k0, sr)); S.st_v1 = load8<TIn>(ROW(Vp, k0, 32 + sr));              \
                         S.st_k0 = load8<TIn>(ROW(Kp, k0, sr)); S.st_k1 = load8<TIn>(ROW(Kp, k0, 32 + sr)); } while (0)
#define SWRITE_HK(bf) do { *(bf16x8*)(K_lds + (bf) * SHM_K + kws) = S.st_k0; *(bf16x8*)(K_lds + (bf) * SHM_K + kws + 32 * 256) = S.st_k1; } while (0)
#define SWRITE_HV(bf) do { *(bf16x8*)(V_lds + (bf) * SHM_V + vst0) = S.st_v0; *(bf16x8*)(V_lds + (bf) * SHM_V + vst1) = S.st_v1; } while (0)
#define SWRITE_H(bf) do { SWRITE_HV(bf); SWRITE_HK(bf); } while (0)
#define SLOAD_F(p, k0) do { S.sf0 = *(const f32x4*)ROW(p, k0, sr); S.sf1 = *(const f32x4*)(ROW(p, k0, sr) + 4);                \
                            S.sf2 = *(const f32x4*)ROW(p, k0, 32 + sr); S.sf3 = *(const f32x4*)(ROW(p, k0, 32 + sr) + 4); } while (0)
#define SWRITE_KF(bf) do { *(bf16x8*)(K_lds + (bf) * SHM_K + kws) = pack8(S.sf0, S.sf1); *(bf16x8*)(K_lds + (bf) * SHM_K + kws + 32 * 256) = pack8(S.sf2, S.sf3); } while (0)
#define SWRITE_VF(bf) do { *(bf16x8*)(V_lds + (bf) * SHM_V + vst0) = pack8(S.sf0, S.sf1); *(bf16x8*)(V_lds + (bf) * SHM_V + vst1) = pack8(S.sf2, S.sf3); } while (0)
template <class TIn, class TOut>
__device__ __forceinline__ void causal_swa_prime(const BlockRef<TIn, TOut>& cur, char* lds, Seam<TIn>& S) {
    constexpr bool F32 = same_t<TIn, float>::v;
    const int tid = otid(), wid = __builtin_amdgcn_readfirstlane(tid >> 6), lane = tid & 63, r32 = lane & 31, hi = lane >> 5;
    const int sr = tid >> 4, sc = (tid & 15) * 8, kws = KSWZ(sr, sc * 2); char* K_lds = lds + 2 * SHM_V;
    const int kb0 = swa_jlo(cur.P0, cur.W) * KVBLK;
    for (int d0 = 0; d0 < 8; ++d0) S.qr[d0] = load8<TIn>(cur.Q + (size_t)(wid * QBLK + r32) * D + d0 * 16 + hi * 8);
    if constexpr (F32) { SLOAD_F((const float*)cur.K, kb0); VMW(); SWRITE_KF(0); SBAR(); SLOAD_F((const float*)cur.V, kb0); }
    else { SLOAD_H(cur.K, cur.V, kb0); VMW(); SWRITE_HK(0); }
    __syncthreads();
}
template <class TIn, class TOut>
__device__ __forceinline__ void causal_swa_block(const BlockRef<TIn, TOut>& cur, const BlockRef<TIn, TOut>& nxt, int skv, char* lds, Seam<TIn>& S) {
    constexpr bool F32 = same_t<TIn, float>::v;
    const int tid = otid(), wid = __builtin_amdgcn_readfirstlane(tid >> 6), lane = tid & 63, r32 = lane & 31, hi = lane >> 5;
    const int j_lo = swa_jlo(cur.P0, cur.W); const float nsl = cur.nsl;
    int j_hi = (cur.P0 + QB - 1) / KVBLK + 1; if (j_hi > skv / KVBLK) j_hi = skv / KVBLK;
    const int NT = j_hi - j_lo;
    const int kbn = swa_jlo(nxt.P0, nxt.W) * KVBLK;
    const int qlo = cur.P0 + wid * QBLK, qlom = qlo | 63, qm = ((qlo + r32) | 63) - 4 * hi, qt4 = qlo + r32 - 4 * hi;
    char* V_lds = lds; char* K_lds = lds + 2 * SHM_V;
    float* ws = (float*)(lds + 2 * SHM_V + 2 * SHM_K) + wid * 64; float* li_l = ws, * al_l = ws + 32;
    float m_reg = 0.f, l_reg = 0; f32x16 o[4] = {};
    const int sr = tid >> 4, sc = (tid & 15) * 8, vst0 = v_st(sr, sc), vst1 = v_st(32 + sr, sc), kws = KSWZ(sr, sc * 2);
    const int vb0 = (int)(uintptr_t)V_lds + v_rd_base(lane);
    const TIn* Kh = cur.K; const TIn* Vh = cur.V;
#define RESC(a) do { if (__any((a) < 1.f)) { if (hi == 0) al_l[r32] = (a); asm volatile("s_waitcnt lgkmcnt(0)" ::: "memory");              \
                     for (int d_ = 0; d_ < 4; ++d_) for (int r = 0; r < 16; ++r) o[d_][r] *= al_l[crow(r, hi)]; } } while (0)
#define KBASE(t) ((j_lo + (t)) * KVBLK)
#define ACT(t) (true)
#define MASKT(P0_, P1_, t) do { const int kb_ = KBASE(t); if (kb_ + KVBLK - 1 > qlom) mask_tile(P0_, P1_, qm - kb_, 0x40000000u); } while (0)
    constexpr int NQL = F32 ? 16 : 8;
    constexpr bool SK = WSKIP && !F32;
#define SEAM_K0() do { VMWN(NQL); if constexpr (F32) { SWRITE_KF(0); SBAR(); SLOAD_F((const float*)nxt.V, kbn); } else { SWRITE_HK(0); } SBAR(); } while (0)
    f32x16 pA0, pA1, pB0, pB1; float mnA, mnB, alA, alB; bf16x8 pa0, pa1, pa2, pa3;
    if constexpr (F32) { VMW(); SWRITE_VF(0); SBAR(); } else { SWRITE_HV(0); SBAR(); }
    if (NT > 1) { if constexpr (F32) SLOAD_F((const float*)Kh, KBASE(1)); else SLOAD_H(Kh, Vh, KBASE(1)); }
    SBAR(); qkt<0, SK>(pA0, pA1, K_lds, r32, hi, S.qr, ACT(0), nsl, (float)(qt4 - KBASE(0)), KBASE(0) + KVBLK - 1 <= qlo, m_reg);
    if constexpr (F32) { if (NT > 1) { VMW(); SWRITE_KF(1); SBAR(); SLOAD_F((const float*)Vh, KBASE(1)); } }
    MASKT(pA0, pA1, 0); partialSM(pA0, pA1, m_reg, mnA, alA);
    if (NT > 1) { VMW(); if constexpr (F32) { SWRITE_VF(1); SBAR(); if (NT > 2) SLOAD_F((const float*)Kh, KBASE(2)); } else SWRITE_H(1); }
    __syncthreads();
#define HALF_STEP(PX0, PX1, mnX, alX, PY0, PY1, alY, t, KB, VB, SB) do {                                                      \
        SBAR(); qkt<KB, SK>(PX0, PX1, K_lds, r32, hi, S.qr, ACT(t), nsl, (float)(qt4 - KBASE(t)), KBASE(t) + KVBLK - 1 <= qlo, m_reg);                                             \
        finishSM(PY0, PY1, alY, l_reg, pa0, pa1, pa2, pa3); SBAR();                                                           \
        if ((t) + 1 < NT) { if constexpr (F32) { VMW(); SWRITE_KF(SB); SBAR(); SLOAD_F((const float*)Vh, KBASE((t) + 1)); }  \
                            else { SLOAD_H(Kh, Vh, KBASE((t) + 1)); } SBAR(); }                                               \
        pv_tile<VB, SK>(o, vb0, pa0, pa1, pa2, pa3, ACT((t) - 1)); MASKT(PX0, PX1, (t)); partialSM(PX0, PX1, m_reg, mnX, alX);                                        \
        __syncthreads();                                                                                                      \
        if ((t) + 1 < NT) { VMW(); if constexpr (F32) { SWRITE_VF(SB); SBAR(); if ((t) + 2 < NT) SLOAD_F((const float*)Kh, KBASE((t) + 2)); } \
                            else { SWRITE_H(SB); } }                                                                          \
        RESC(alX); __syncthreads(); } while (0)
    for (int t = 1; t + 1 < NT; t += 2) {
        HALF_STEP(pB0, pB1, mnB, alB, pA0, pA1, alA, t, 1, 0, 0);
        HALF_STEP(pA0, pA1, mnA, alA, pB0, pB1, alB, t + 1, 0, 1, 1);
    }
    const bool even = (NT & 1) == 0;
    if (even) { SBAR(); qkt<1, SK>(pB0, pB1, K_lds, r32, hi, S.qr, ACT(NT - 1), nsl, (float)(qt4 - KBASE(NT - 1)), KBASE(NT - 1) + KVBLK - 1 <= qlo, m_reg); SBAR(); }
#define QROW(e) (nxt.Q + (size_t)(wid * QBLK + r32) * D + ((e) >> 1) * 16 + hi * 8 + ((e) & 1) * 4)
    if constexpr (F32) { SLOAD_F((const float*)nxt.K, kbn); SBAR();
#pragma unroll
        for (int e = 0; e < 8; ++e) S.tq[e] = *(const f32x4*)QROW(e); }
    else { SLOAD_H(nxt.K, nxt.V, kbn); SBAR();
#pragma unroll
        for (int d0 = 0; d0 < 8; ++d0) S.qr[d0] = load8<TIn>(nxt.Q + (size_t)(wid * QBLK + r32) * D + d0 * 16 + hi * 8); }
    SBAR();
    finishSM(pA0, pA1, alA, l_reg, pa0, pa1, pa2, pa3); SBAR();
    if constexpr (F32) {
#pragma unroll
        for (int e = 8; e < 16; ++e) S.tq[e] = *(const f32x4*)QROW(e); SBAR(); }
#undef QROW
    pv_tile<0, SK>(o, vb0, pa0, pa1, pa2, pa3, ACT(even ? NT - 2 : NT - 1));
    if (even) { MASKT(pB0, pB1, NT - 1); partialSM(pB0, pB1, m_reg, mnB, alB); __syncthreads(); RESC(alB);
        finishSM(pB0, pB1, alB, l_reg, pa0, pa1, pa2, pa3); SBAR(); pv_tile<1, SK>(o, vb0, pa0, pa1, pa2, pa3, ACT(NT - 1)); }
    SBAR(); SEAM_K0();
    if (hi == 0) li_l[r32] = l_reg; asm volatile("s_waitcnt lgkmcnt(0)" ::: "memory");
    float rli[16];
#pragma unroll
    for (int r = 0; r < 16; ++r) rli[r] = __builtin_amdgcn_rcpf(li_l[crow(r, hi)]);
    TOut* Ow = cur.O + (size_t)(wid * QBLK) * D;
#pragma unroll
    for (int r = 0; r < 16; ++r) { const int orow = crow(r, hi);
#pragma unroll
        for (int d0 = 0; d0 < 4; ++d0) { const float v = o[d0][r] * rli[r];
            if constexpr (same_t<TOut, float>::v) { Ow[(size_t)orow * D + d0 * 32 + r32] = v; }
            else { const float vn = __shfl_xor(v, 1);
                   if ((r32 & 1) == 0) *(unsigned*)(Ow + (size_t)orow * D + d0 * 32 + r32) = cvtpk(v, vn); } } }
    if constexpr (F32) {
#pragma unroll
        for (int d0 = 0; d0 < 8; ++d0) S.qr[d0] = pack8(S.tq[2 * d0], S.tq[2 * d0 + 1]); }
    __syncthreads();
#undef RESC
#undef KBASE
#undef ACT
#undef MASKT
#undef SEAM_K0
#undef HALF_STEP
}
#undef ROW
#undef VMW
#undef VMWN
#undef SLOAD_H
#undef SWRITE_HK
#undef SWRITE_HV
#undef SWRITE_H
#undef SLOAD_F
#undef SWRITE_KF
#undef SWRITE_VF

}
#ifndef MK_PER_PHASE
#define MK_PER_PHASE 0
#endif
#define MK_PH_HI 16
#define MK_GDN_SIMPLE 0
#define MK_ATT_WINDOW 1
#ifndef MK_DUP_MASK
#define MK_DUP_MASK 0
#endif
#ifndef MK_GDN_SIMPLE
#define MK_GDN_SIMPLE 1
#endif

#define LAS __attribute__((address_space(3)))
typedef unsigned short u16;
typedef short v8s __attribute__((ext_vector_type(8)));
typedef float v4f __attribute__((ext_vector_type(4)));
typedef float v16f __attribute__((ext_vector_type(16)));
typedef unsigned v4u __attribute__((ext_vector_type(4)));
typedef unsigned v2u __attribute__((ext_vector_type(2)));

constexpr int S_ = 8192, DM = 2048, NQKV = 6144, DFF = 5504, NUP = 11008, GIN = 12352, GINP = 12544, GV = 4096;
constexpr float EPS = 1e-6f;
constexpr size_t MiB = 1u << 20;
constexpr size_t WS_MISC = 0;
constexpr size_t WS_WUP1 = 1 * MiB, WS_WDN1 = 44 * MiB, WS_WIN = 66 * MiB, WS_WOUT = 115 * MiB;
constexpr size_t WS_XB = 131 * MiB;
constexpr size_t WS_WQKV = 163 * MiB, WS_WO = 187 * MiB, WS_WUP0 = 195 * MiB, WS_WDN0 = 238 * MiB;
constexpr size_t WS_QH = 260 * MiB, WS_KH = 292 * MiB, WS_VH = 324 * MiB, WS_OATT = 356 * MiB, WS_OB = 484 * MiB;
constexpr size_t WS_U = 260 * MiB, WS_Y = 432 * MiB;
constexpr size_t WS_PQKV = 163 * MiB, WS_Z = 291 * MiB, WS_BA = 355 * MiB, WS_OPS = 357 * MiB;
constexpr size_t WS_OG = WS_PQKV;
constexpr size_t WS_OGN = WS_OPS;
constexpr size_t WS_SSQ = 652 * MiB;
constexpr size_t WS_SQ = 357 * MiB, WS_SK = 421 * MiB, WS_SV = 485 * MiB, WS_SG = 613 * MiB;
#ifndef MK_HYBRID
#define MK_HYBRID 0
#endif
#ifndef MK_CHECK
#define MK_CHECK 0
#endif
constexpr size_t WS_OPS_H = 615 * MiB;
constexpr size_t WS_END = MK_HYBRID ? 688 * MiB : 656 * MiB;
static_assert(WS_KH - WS_QH == 32 * MiB && WS_VH - WS_KH == 32 * MiB, "EpiQKV tensor stride");
constexpr int OPS_BLK = 73984, OP_GL = 73728;
constexpr int OP_W = 0, OP_QD = 16384, OP_QK = 32768, OP_KD = 40960, OP_U = 57344;
constexpr int SCAN_BUF = 61440;
constexpr int LDS_BYTES = 155648;
constexpr int XCH_OFF = 131072;

typedef __bf16 bf16x2_t __attribute__((ext_vector_type(2)));
typedef float f32x2_t __attribute__((ext_vector_type(2)));
__device__ __forceinline__ unsigned cvtpk(float lo, float hi) { f32x2_t v = {lo, hi}; bf16x2_t r = __builtin_convertvector(v, bf16x2_t); return __builtin_bit_cast(unsigned, r); }
__device__ __forceinline__ u16 f2bf(float f) { return (u16)(cvtpk(f, 0.f) & 0xffffu); }
__device__ __forceinline__ float bf2f(u16 b) { return __uint_as_float(((unsigned)b) << 16); }
__device__ __forceinline__ float bflo(unsigned w) { return __uint_as_float(w << 16); }
__device__ __forceinline__ float bfhi(unsigned w) { return __uint_as_float(w & 0xffff0000u); }
__device__ __forceinline__ v8s pack8f(float a0, float a1, float a2, float a3, float a4, float a5, float a6, float a7) {
    v4u w = {cvtpk(a0, a1), cvtpk(a2, a3), cvtpk(a4, a5), cvtpk(a6, a7)}; return *reinterpret_cast<v8s*>(&w); }
__device__ __forceinline__ float wave_sum(float v) {
#pragma unroll
    for (int o = 1; o < 64; o <<= 1) v += __shfl_xor(v, o);
    return v; }
template <int CTRL> __device__ __forceinline__ float dpp_f(float v) { return __int_as_float(__builtin_amdgcn_update_dpp(0, __float_as_int(v), CTRL, 0xF, 0xF, false)); }
__device__ __forceinline__ float silu_f(float y) { return y * __builtin_amdgcn_rcpf(1.f + __expf(-y)); }
#define LDS_WAIT() asm volatile("s_waitcnt lgkmcnt(0)" ::: "memory")
#define VM_WAIT() asm volatile("s_waitcnt vmcnt(0)" ::: "memory")

struct Params { const float* in[22]; float* out; unsigned char* ws; int ph_lo, ph_hi; };
struct EpiQKV {
    static constexpr bool PERM = true, AFTER_DRAIN = false;
    u16* Qh;
    __device__ __forceinline__ void operator()(const pg8::f32x4 (&acc)[2][2][4][2], const pg8::Unit& u, int wr, int wc, int fr, int fq) const {
        asm volatile("" : "+v"(fr), "+v"(fq));
        const int tensor = u.pn >> 3, hh0 = 2 * (u.pn & 7);
        u16* T = Qh + (size_t)tensor * (16u << 20);
        const int cl = wc * 32 + fq * 8;
#pragma unroll
        for (int ai = 0; ai < 2; ++ai)
#pragma unroll
            for (int m = 0; m < 4; ++m) {
                const size_t row = (size_t)u.pm * 256 + ai * 128 + wr * 64 + m * 16 + fr;
#pragma unroll
                for (int bj = 0; bj < 2; ++bj) {
                    const pg8::f32x4 a = acc[ai][bj][m][0], b = acc[ai][bj][m][1];
                    v4u w; w.x = cvtpk(a[0], a[1]); w.y = cvtpk(a[2], a[3]); w.z = cvtpk(b[0], b[1]); w.w = cvtpk(b[2], b[3]);
                    *(v4u*)(T + ((size_t)(hh0 + bj) * S_ + row) * 128 + cl) = w;
                }
            }
    }
};
__device__ __forceinline__ void phase_qknorm(const Params& p) {
    const int tid = otid(), lane = tid & 63, wave = tid >> 6;
    const int gw = blockIdx.x * 8 + wave, NGW = gridDim.x * 8;
    u16* QK = (u16*)(p.ws + WS_QH);
    const int e0 = 4 * (lane & 31);
    for (int it0 = gw * 4; it0 < 2 * 16 * S_ / 2; it0 += NGW * 4) {
        v2u w[4]; float ss[4];
#pragma unroll
        for (int u = 0; u < 4; ++u) w[u] = *(const v2u*)(QK + ((size_t)(it0 + u) * 2 + (lane >> 5)) * 128 + e0);
#pragma unroll
        for (int u = 0; u < 4; ++u) { const float x0 = bflo(w[u].x), x1 = bfhi(w[u].x), x2 = bflo(w[u].y), x3 = bfhi(w[u].y); ss[u] = (x0 * x0 + x1 * x1) + (x2 * x2 + x3 * x3); }
#pragma unroll
        for (int o = 1; o < 32; o <<= 1) {
#pragma unroll
            for (int u = 0; u < 4; ++u) ss[u] += __shfl_xor(ss[u], o); }
#pragma unroll
        for (int u = 0; u < 4; ++u) {
            const size_t r = (size_t)(it0 + u) * 2 + (lane >> 5); const int tensor = (int)(r >> 17);
            const v4f g = *(const v4f*)((tensor ? p.in[5] : p.in[4]) + e0);
            const float x0 = bflo(w[u].x), x1 = bfhi(w[u].x), x2 = bflo(w[u].y), x3 = bfhi(w[u].y);
            const float rs = __builtin_amdgcn_rsqf(ss[u] * (1.f / 128.f) + EPS) * (tensor ? 1.f : 0.12751743082459868f);
            v2u o2; o2.x = cvtpk(x0 * rs * g[0], x1 * rs * g[1]); o2.y = cvtpk(x2 * rs * g[2], x3 * rs * g[3]);
            *(v2u*)(QK + r * 128 + e0) = o2;
        }
    }
}
struct EpiRes {
    static constexpr bool PERM = false, AFTER_DRAIN = false;
    const float* base; float* out; u16* xb; float* ssq;
    __device__ __forceinline__ void operator()(const pg8::f32x4 (&acc)[2][2][4][2], const pg8::Unit& u, int wr, int wc, int fr, int fq) const {
        asm volatile("" : "+v"(fr), "+v"(fq));
        const int col0 = u.pn * 256 + wc * 32 + 4 * fq;
#pragma unroll
        for (int ai = 0; ai < 2; ++ai)
#pragma unroll
            for (int m = 0; m < 4; ++m) {
                const size_t row = (size_t)u.pm * 256 + ai * 128 + wr * 64 + m * 16 + fr; const size_t off = row * DM + col0; float s = 0.f;
#pragma unroll
                for (int bj = 0; bj < 2; ++bj)
#pragma unroll
                    for (int n = 0; n < 2; ++n) {
                        const size_t o = off + bj * 128 + n * 16;
                        const v4f bs = *(const v4f*)(base + o); const pg8::f32x4 a = acc[ai][bj][m][n];
                        v4f v; v[0] = bs[0] + a[0]; v[1] = bs[1] + a[1]; v[2] = bs[2] + a[2]; v[3] = bs[3] + a[3];
                        *(v4f*)(out + o) = v;
                        if (xb) { v2u w; w.x = cvtpk(v[0], v[1]); w.y = cvtpk(v[2], v[3]); *(v2u*)(xb + o) = w; }
                        s += (v[0] * v[0] + v[1] * v[1]) + (v[2] * v[2] + v[3] * v[3]);
                    }
                if (ssq) { s += __shfl_xor(s, 16); s += __shfl_xor(s, 32); if (fq == 0) ssq[((size_t)u.pn * S_ + row) * 4 + wc] = s; }
            }
    }
};
struct EpiScale {
    static constexpr bool PERM = true, AFTER_DRAIN = false;
    const float* ssq; u16* O0; int ld0; int n0;
    u16* O1; int ld1; int n1;
    float* O2; int ld2; int n2;
    __device__ __forceinline__ void operator()(const pg8::f32x4 (&acc)[2][2][4][2], const pg8::Unit& u, int wr, int wc, int fr, int fq) const {
        asm volatile("" : "+v"(fr), "+v"(fq));
        const int colt = u.pn * 256; const int cl = wc * 32 + fq * 8;
#pragma unroll
        for (int ai = 0; ai < 2; ++ai)
#pragma unroll
            for (int m = 0; m < 4; ++m) {
                const size_t row = (size_t)u.pm * 256 + ai * 128 + wr * 64 + m * 16 + fr;
                float sq = 0.f;
#pragma unroll
                for (int t = 0; t < 8; ++t) { const v4f q4 = *(const v4f*)(ssq + ((size_t)t * S_ + row) * 4); sq += (q4[0] + q4[1]) + (q4[2] + q4[3]); }
                const float rs = __builtin_amdgcn_rsqf(sq * (1.f / 2048.f) + EPS);
#pragma unroll
                for (int bj = 0; bj < 2; ++bj) {
                    const int col = colt + bj * 128 + cl;
                    const pg8::f32x4 a = acc[ai][bj][m][0], b = acc[ai][bj][m][1];
                    if (colt < n1) {
                        v4u w; w.x = cvtpk(a[0] * rs, a[1] * rs); w.y = cvtpk(a[2] * rs, a[3] * rs); w.z = cvtpk(b[0] * rs, b[1] * rs); w.w = cvtpk(b[2] * rs, b[3] * rs);
                        if (colt < n0) *(v4u*)(O0 + row * ld0 + col) = w; else *(v4u*)(O1 + row * ld1 + (col - n0)) = w;
                    } else if (col < n2) {
                        float* p = O2 + row * ld2 + (col - n1);
                        v4f x = {a[0] * rs, a[1] * rs, a[2] * rs, a[3] * rs}, y = {b[0] * rs, b[1] * rs, b[2] * rs, b[3] * rs};
                        *(v4f*)p = x; *(v4f*)(p + 4) = y;
                    }
                }
            }
    }
};

__device__ __forceinline__ void transpose_item(const float* W, int K, int N, u16* WT, const float* gain, LAS float* scr, int item, int lane) {
    const int nblk = N / 32, kb = item / nblk, nb = item % nblk, k0 = 64 * kb, n0 = 32 * nb;
    float tv[32];
#pragma unroll
    for (int i = 0; i < 32; ++i) tv[i] = W[(size_t)(k0 + 2 * i + (lane >> 5)) * N + n0 + (lane & 31)];
#pragma unroll
    for (int i = 0; i < 32; ++i) { const int kk = 2 * i + (lane >> 5); float v = tv[i]; if (gain) v *= gain[k0 + kk]; scr[kk * 33 + (lane & 31)] = v; }
    LDS_WAIT(); asm volatile("" ::: "memory");
    const int c = lane & 7;
#pragma unroll
    for (int j = 0; j < 4; ++j) { const int n = (lane >> 3) + 8 * j; const LAS float* s = scr + (8 * c) * 33 + n;
        v4u o; o.x = cvtpk(s[0 * 33], s[1 * 33]); o.y = cvtpk(s[2 * 33], s[3 * 33]); o.z = cvtpk(s[4 * 33], s[5 * 33]); o.w = cvtpk(s[6 * 33], s[7 * 33]);
        *(v4u*)(WT + (size_t)(n0 + n) * K + k0 + 8 * c) = o; }
    LDS_WAIT(); asm volatile("" ::: "memory");
}

__device__ __forceinline__ void phase_p0(const Params& p, LAS unsigned char* lds) {
    const int tid = otid(), lane = tid & 63, wave = tid >> 6;
    LAS float* scr = (LAS float*)(lds + wave * 16384);
    const int gw = blockIdx.x * 8 + wave, NGW = gridDim.x * 8;
    unsigned char* ws = p.ws;
    constexpr int I_QKV = 32 * 192, I_O = 32 * 64, I_UP = 32 * 344, I_DN = 86 * 64, I_IN = 32 * 386, I_OUT = 64 * 64;
    constexpr int NIT = I_QKV + I_O + I_UP + I_DN + I_IN;
    (void)I_OUT;
    for (int it = gw; it < NIT; it += NGW) {
        int r = it;
        if (r < I_QKV) { transpose_item(p.in[3], DM, NQKV, (u16*)(ws + WS_WQKV), nullptr, scr, r, lane); continue; } r -= I_QKV;
        if (r < I_O) { transpose_item(p.in[11], DM, DM, (u16*)(ws + WS_WO), nullptr, scr, r, lane); continue; } r -= I_O;
        if (r < I_UP) { transpose_item(p.in[18], DM, NUP, (u16*)(ws + WS_WUP0), p.in[2], scr, r, lane); continue; } r -= I_UP;
        if (r < I_DN) { transpose_item(p.in[21], DFF, DM, (u16*)(ws + WS_WDN0), nullptr, scr, r, lane); continue; } r -= I_DN;
        transpose_item(p.in[12], DM, GIN, (u16*)(ws + WS_WIN), p.in[1] + DM, scr, r, lane);
    }
    { const size_t gt = (size_t)blockIdx.x * 512 + tid, NT = (size_t)gridDim.x * 512;
      v4u z = {0u, 0u, 0u, 0u}; v4u* pz = (v4u*)(ws + WS_WIN + (size_t)GIN * DM * 2);
      for (size_t i = gt; i < (size_t)(GINP - GIN) * DM * 2 / 16; i += NT) pz[i] = z;
    }
    if (blockIdx.x == 0 && tid < 16) ((unsigned*)(ws + WS_MISC))[tid] = 0u;
    const float* x = p.in[0]; const float* g = p.in[1]; u16* xb = (u16*)(ws + WS_XB);
    for (int row = gw; row < S_; row += NGW) {
        const v4f* xr = (const v4f*)(x + (size_t)row * DM) + lane; v4f v[8]; float s = 0.f;
#pragma unroll
        for (int j = 0; j < 8; ++j) { v[j] = xr[64 * j]; s += (v[j][0] * v[j][0] + v[j][1] * v[j][1]) + (v[j][2] * v[j][2] + v[j][3] * v[j][3]); }
        const float rs = __builtin_amdgcn_rsqf(wave_sum(s) * (1.f / DM) + EPS);
#pragma unroll
        for (int j = 0; j < 8; ++j) { const v4f gg = *((const v4f*)g + lane + 64 * j);
            v2u w; w.x = cvtpk(v[j][0] * rs * gg[0], v[j][1] * rs * gg[1]); w.y = cvtpk(v[j][2] * rs * gg[2], v[j][3] * rs * gg[3]);
            *((v2u*)(xb + (size_t)row * DM) + lane + 64 * j) = w; }
    }
}

__device__ __forceinline__ void phase_p0_late(const Params& p, LAS unsigned char* lds, int widx, int nw) {
    const int tid = otid(), lane = tid & 63, wave = tid >> 6;
    LAS float* scr = (LAS float*)(lds + wave * 16384);
    unsigned char* ws = p.ws;
    constexpr int I_UP = 32 * 344, I_DN = 86 * 64, I_OUT = 64 * 64;
    for (int it = widx * 8 + wave; it < I_UP + I_DN + I_OUT; it += nw * 8) {
        int r = it;
        if (r < I_UP) { transpose_item(p.in[18] + (size_t)DM * NUP, DM, NUP, (u16*)(ws + WS_WUP1), p.in[2] + DM, scr, r, lane); continue; } r -= I_UP;
        if (r < I_DN) { transpose_item(p.in[21] + (size_t)DFF * DM, DFF, DM, (u16*)(ws + WS_WDN1), nullptr, scr, r, lane); continue; } r -= I_DN;
        transpose_item(p.in[17], GV, DM, (u16*)(ws + WS_WOUT), nullptr, scr, r, lane);
    }
}
__device__ __forceinline__ att::BlockRef<att::bf16, float> attn_ref(int m32, int qb, const u16* Qh, const u16* Kh, const u16* Vh, float* O, const char* ldsb) {
    const int map = m32 >> 1, c = m32 & 1, h = map >> 1;
    const float wnum = __int_as_float(__builtin_amdgcn_readfirstlane(*(const LAS int*)((const LAS char*)ldsb + 68608)));
    att::BlockRef<att::bf16, float> r;
    r.Q = (const att::bf16*)(Qh + ((size_t)map * S_ + (size_t)qb * 256) * 128);
    r.K = (const att::bf16*)(Kh + (size_t)map * S_ * 128);
    r.V = (const att::bf16*)(Vh + (size_t)(h * 2 + c) * S_ * 128);
    r.O = O + ((size_t)m32 * S_ + (size_t)qb * 256) * 128;
    const float slope = __builtin_amdgcn_exp2f(-(float)(h + 1));
    int jlo = 0;
#if MK_ATT_WINDOW && !MK_HYBRID
    { const float wf = wnum / slope + 65.f; const int W = wf < 1.0e9f ? (int)wf : (1 << 30); const int lowk = qb * 256 - W + 1; jlo = lowk > 0 ? lowk / 256 : 0; }
#endif
    r.K += (size_t)jlo * 256 * 128; r.V += (size_t)jlo * 256 * 128;
    r.P0 = (qb - jlo) * 256; r.W = 1 << 30;
    r.nsl = -slope * 1.4426950408889634f;
    return r;
}
struct AttItem { int m32, qb0, qb1; };
__device__ __forceinline__ AttItem attn_decode(int L) {
    const int xcd = L & 7, k = L >> 3, gi = k >> 4, r = k & 15; AttItem it;
    it.m32 = (xcd + 8 * (gi >> 1)) * 2 + (gi & 1); it.qb0 = r; it.qb1 = 31 - r; return it;
}
__device__ __forceinline__ void phase_attn(const Params& p, char* lds) {
    const u16* Qh = (const u16*)(p.ws + WS_QH); const u16* Kh = (const u16*)(p.ws + WS_KH); const u16* Vh = (const u16*)(p.ws + WS_VH); float* O = (float*)(p.ws + WS_OATT);
    constexpr int total = 512; const int stride = gridDim.x;
    int L = blockIdx.x; if (L >= total) return;
    float wnum;
    { const int lane = otid() & 63;
      float mq = fmaxf(__builtin_fabsf(p.in[4][lane]), __builtin_fabsf(p.in[4][lane + 64])), mk = fmaxf(__builtin_fabsf(p.in[5][lane]), __builtin_fabsf(p.in[5][lane + 64]));
#pragma unroll
      for (int o = 1; o < 64; o <<= 1) { mq = fmaxf(mq, __shfl_xor(mq, o)); mk = fmaxf(mk, __shfl_xor(mk, o)); }
      wnum = 104.f + 2.f * 1.02f * 11.313708498984761f * mq * mk;
      if (otid() == 0) *(LAS float*)((LAS char*)lds + 68608) = wnum; }
    __syncthreads();
    AttItem it = attn_decode(L); int pass = 0;
    att::BlockRef<att::bf16, float> cur = attn_ref(it.m32, it.qb0, Qh, Kh, Vh, O, lds);
    att::Seam<att::bf16> S;
    att::causal_swa_prime<att::bf16, float>(cur, lds, S);
    for (;;) {
        const bool more_pass = pass == 0, more_item = L + stride < total, last = !more_pass && !more_item;
        AttItem itn = it; int passn = pass + 1, Ln = L;
        if (!more_pass) { passn = 0; Ln = more_item ? L + stride : L; itn = attn_decode(Ln); }
        const att::BlockRef<att::bf16, float> nxt = last ? cur : attn_ref(itn.m32, passn ? itn.qb1 : itn.qb0, Qh, Kh, Vh, O, lds);
        att::causal_swa_block<att::bf16, float>(cur, nxt, S_, lds, S);
        if (last) break;
        cur = nxt; it = itn; pass = passn; L = Ln;
    }
}
__device__ __forceinline__ void phase_combine(const Params& p) {
    const int tid = otid(), lane = tid & 63, wave = tid >> 6;
    const int gw = blockIdx.x * 8 + wave, NGW = gridDim.x * 8;
    float s1 = p.in[6][lane] * p.in[7][lane] + p.in[6][lane + 64] * p.in[7][lane + 64];
    float s2 = p.in[8][lane] * p.in[9][lane] + p.in[8][lane + 64] * p.in[9][lane + 64];
    s1 = wave_sum(s1); s2 = wave_sum(s2);
    const float lam = __expf(s1) - __expf(s2) + 0.2f;
    const float* O = (const float*)(p.ws + WS_OATT); u16* OB = (u16*)(p.ws + WS_OB);
    const int e0 = 4 * lane, c = e0 >> 7, wi = e0 & 127;
    const v4f sg = *(const v4f*)(p.in[10] + e0);
    for (int it0 = gw * 4; it0 < S_ * 8; it0 += NGW * 4) {
        v4f a[4], b[4], v[4]; float ss[4];
#pragma unroll
        for (int u = 0; u < 4; ++u) { const int it = it0 + u, t = it >> 3, h = it & 7;
            a[u] = *(const v4f*)(O + ((size_t)((4 * h + c)) * S_ + t) * 128 + wi);
            b[u] = *(const v4f*)(O + ((size_t)((4 * h + 2 + c)) * S_ + t) * 128 + wi); }
#pragma unroll
        for (int u = 0; u < 4; ++u) { v[u][0] = a[u][0] - lam * b[u][0]; v[u][1] = a[u][1] - lam * b[u][1]; v[u][2] = a[u][2] - lam * b[u][2]; v[u][3] = a[u][3] - lam * b[u][3];
            ss[u] = (v[u][0] * v[u][0] + v[u][1] * v[u][1]) + (v[u][2] * v[u][2] + v[u][3] * v[u][3]); }
#pragma unroll
        for (int o = 1; o < 64; o <<= 1) {
#pragma unroll
            for (int u = 0; u < 4; ++u) ss[u] += __shfl_xor(ss[u], o); }
#pragma unroll
        for (int u = 0; u < 4; ++u) { const int it = it0 + u, t = it >> 3, h = it & 7;
            const float rs = __builtin_amdgcn_rsqf(ss[u] * (1.f / 256.f) + EPS) * 0.8f;
            v2u w; w.x = cvtpk(v[u][0] * rs * sg[0], v[u][1] * rs * sg[1]); w.y = cvtpk(v[u][2] * rs * sg[2], v[u][3] * rs * sg[3]);
            *(v2u*)(OB + (size_t)t * DM + h * 256 + e0) = w; }
    }
}

__device__ __forceinline__ void unpack8(const v4u w, float (&f)[8]) { f[0] = bflo(w.x); f[1] = bfhi(w.x); f[2] = bflo(w.y); f[3] = bfhi(w.y); f[4] = bflo(w.z); f[5] = bfhi(w.z); f[6] = bflo(w.w); f[7] = bfhi(w.w); }
__device__ __forceinline__ void phase_convgate(const Params& p, int layer) {
    const u16* U = (const u16*)(p.ws + WS_U); u16* Y = (u16*)(p.ws + WS_Y);
    const float* cw = p.in[19] + (size_t)layer * 3 * NUP; const float* cb = p.in[20] + (size_t)layer * NUP;
    constexpr int NCG = DFF / 8, RUN = 16, NRUN = S_ / RUN;
    const size_t gt = (size_t)blockIdx.x * 512 + otid(), NT = (size_t)gridDim.x * 512;
    for (size_t idx = gt; idx < (size_t)NCG * NRUN; idx += NT) {
        const int cg8 = (int)(idx % NCG) * 8, t0 = (int)(idx / NCG) * RUN;
        float wv[3][8], wg[3][8], bv[8], bg[8];
#pragma unroll
        for (int j = 0; j < 3; ++j)
#pragma unroll
            for (int e = 0; e < 8; ++e) { wv[j][e] = cw[j * NUP + cg8 + e]; wg[j][e] = cw[j * NUP + DFF + cg8 + e]; }
#pragma unroll
        for (int e = 0; e < 8; ++e) { bv[e] = cb[cg8 + e]; bg[e] = cb[DFF + cg8 + e]; }
        float v2[8], v1[8], g2[8], g1[8];
#pragma unroll
        for (int e = 0; e < 8; ++e) { v2[e] = v1[e] = g2[e] = g1[e] = 0.f; }
        if (t0 >= 2) {
            unpack8(*(const v4u*)(U + (size_t)(t0 - 2) * NUP + cg8), v2); unpack8(*(const v4u*)(U + (size_t)(t0 - 1) * NUP + cg8), v1);
            unpack8(*(const v4u*)(U + (size_t)(t0 - 2) * NUP + DFF + cg8), g2); unpack8(*(const v4u*)(U + (size_t)(t0 - 1) * NUP + DFF + cg8), g1);
        }
#pragma unroll
        for (int t = t0; t < t0 + RUN; ++t) {
            float v0[8], g0[8];
            unpack8(*(const v4u*)(U + (size_t)t * NUP + cg8), v0); unpack8(*(const v4u*)(U + (size_t)t * NUP + DFF + cg8), g0);
            float y[8];
#pragma unroll
            for (int e = 0; e < 8; ++e) {
                const float val = wv[0][e] * v2[e] + wv[1][e] * v1[e] + wv[2][e] * v0[e] + bv[e];
                const float gat = wg[0][e] * g2[e] + wg[1][e] * g1[e] + wg[2][e] * g0[e] + bg[e];
                y[e] = silu_f(gat) * val; v2[e] = v1[e]; v1[e] = v0[e]; g2[e] = g1[e]; g1[e] = g0[e];
            }
            v4u w = {cvtpk(y[0], y[1]), cvtpk(y[2], y[3]), cvtpk(y[4], y[5]), cvtpk(y[6], y[7])};
            *(v4u*)(Y + (size_t)t * DFF + cg8) = w;
        }
    }
}

__device__ __forceinline__ int crow(int r, int hi) { return (r & 3) + 8 * (r >> 2) + 4 * hi; }
__device__ __forceinline__ v16f mm_tile(v16f c, const LAS u16* A, int lda, const LAS u16* Bt, int ldb, int K, int lane) {
    const int m = lane & 31, hi = lane >> 5;
    for (int k0 = 0; k0 < K; k0 += 16) {
        const v8s a = *(const LAS v8s*)(A + m * lda + k0 + 8 * hi); const v8s b = *(const LAS v8s*)(Bt + m * ldb + k0 + 8 * hi);
        c = __builtin_amdgcn_mfma_f32_32x32x16_bf16(a, b, c, 0, 0, 0);
    }
    return c;
}
__device__ __forceinline__ void phase_ba(const Params& p, LAS unsigned char* lds) {
    const int tid = otid(), lane = tid & 63, wave = __builtin_amdgcn_readfirstlane(tid >> 6), m = lane & 31, hi = lane >> 5;
    const u16* XBp = (const u16*)(p.ws + WS_XB); const u16* Wb = (const u16*)(p.ws + WS_WIN) + (size_t)12288 * DM;
    const float* ssq = (const float*)(p.ws + WS_SSQ) + 32 * S_; float* BA = (float*)(p.ws + WS_BA);
    LAS float* red = (LAS float*)lds;
    for (int b = blockIdx.x; b < S_ / 32; b += gridDim.x) {
        __syncthreads();
        v16f c0, c1;
#pragma unroll
        for (int r = 0; r < 16; ++r) { c0[r] = 0.f; c1[r] = 0.f; }
        const u16* ap = XBp + (size_t)(32 * b + m) * DM + wave * 256 + 8 * hi;
        const u16* b0p = Wb + (size_t)m * DM + wave * 256 + 8 * hi; const u16* b1p = b0p + (size_t)32 * DM;
#pragma unroll
        for (int half = 0; half < 2; ++half) {
            v8s af[8], bf0[8], bf1[8];
#pragma unroll
            for (int k = 0; k < 8; ++k) { const int ko = (half * 8 + k) * 16; af[k] = *(const v8s*)(ap + ko); bf0[k] = *(const v8s*)(b0p + ko); bf1[k] = *(const v8s*)(b1p + ko); }
#pragma unroll
            for (int k = 0; k < 8; ++k) { c0 = __builtin_amdgcn_mfma_f32_32x32x16_bf16(af[k], bf0[k], c0, 0, 0, 0); c1 = __builtin_amdgcn_mfma_f32_32x32x16_bf16(af[k], bf1[k], c1, 0, 0, 0); }
        }
#pragma unroll
        for (int r = 0; r < 16; ++r) { red[((wave * 2 + 0) * 64 + lane) * 16 + r] = c0[r]; red[((wave * 2 + 1) * 64 + lane) * 16 + r] = c1[r]; }
        __syncthreads();
        for (int e = tid; e < 2 * 64 * 16; e += 512) {
            const int j = e >> 10, l = (e >> 4) & 63, r = e & 15;
            float s = 0.f;
#pragma unroll
            for (int w = 0; w < 8; ++w) s += red[((w * 2 + j) * 64 + l) * 16 + r];
            const int row = 32 * b + crow(r, l >> 5), col = 32 * j + (l & 31);
            float sq = 0.f;
#pragma unroll
            for (int t = 0; t < 8; ++t) { const v4f q4 = *(const v4f*)(ssq + ((size_t)t * S_ + row) * 4); sq += (q4[0] + q4[1]) + (q4[2] + q4[3]); }
            BA[(size_t)row * 64 + col] = s * __builtin_amdgcn_rsqf(sq * (1.f / 2048.f) + EPS);
        }
    }
}
constexpr int PL_KB = 0, PL_QB = 17408, PL_KK = 34816, PL_QK = 51456, PL_GT = 68096, PL_HD = 69632;
constexpr int PL_KBE = PL_HD, PL_VBT = PL_HD + 18432, PL_PB = PL_HD + 36864, PL_PBT = PL_HD + 46080, PL_TB = PL_HD + 55296;
constexpr int PL_XQ = PL_HD, PL_XK = PL_HD + 33024;
static_assert(PL_XK + 33024 <= LDS_BYTES, "prep LDS");

template <bool FROM_S, int HQ_LIM> __device__ __forceinline__ void phase_gdn_prep(const Params& p, LAS unsigned char* lds) {
    const int tid = otid(), lane = tid & 63, wave = __builtin_amdgcn_readfirstlane(tid >> 6), n = lane & 31, hi = lane >> 5;
    const u16* PQ = (const u16*)(p.ws + WS_PQKV); const float* BA = (const float*)(p.ws + WS_BA);
    unsigned char* OPS = p.ws + (FROM_S ? WS_OPS_H : WS_OPS);
    const float* cw = p.in[13];
    const float* SQ = (const float*)(p.ws + WS_SQ); const float* SK = (const float*)(p.ws + WS_SK); const float* SV = (const float*)(p.ws + WS_SV); const float* SG = (const float*)(p.ws + WS_SG);
    LAS u16* Kb = (LAS u16*)(lds + PL_KB); LAS u16* Qb = (LAS u16*)(lds + PL_QB);
    LAS float* KKf = (LAS float*)(lds + PL_KK); LAS float* QKf = (LAS float*)(lds + PL_QK);
    LAS float* beta = (LAS float*)(lds + PL_GT); LAS float* gc = beta + 128; LAS float* rsq = beta + 256;
    LAS u16* KbeT = (LAS u16*)(lds + PL_KBE); LAS u16* VbT = (LAS u16*)(lds + PL_VBT);
    LAS float* Lf = (LAS float*)(lds + PL_PB); LAS u16* Tb = (LAS u16*)(lds + PL_TB);
    LAS float* Xq = (LAS float*)(lds + PL_XQ); LAS float* Xk = (LAS float*)(lds + PL_XK);
    for (int item = blockIdx.x; item < HQ_LIM * 128; item += gridDim.x) {
        const int hq = item >> 7, ch = item & 127, t0 = ch * 64;
        __syncthreads();
      if constexpr (FROM_S) {
        if (tid < 128) {
            const int hvl = tid >> 6, hv = 2 * hq + hvl, tok = tid & 63;
            float g = SG[((size_t)(t0 + tok) * 32 + hv) * 2]; const float be = SG[((size_t)(t0 + tok) * 32 + hv) * 2 + 1];
#pragma unroll
            for (int o = 1; o < 64; o <<= 1) { const float t = __shfl_up(g, o); if (tok >= o) g += t; }
            beta[hvl * 64 + tok] = be; gc[hvl * 64 + tok] = g;
            if (tok == 63) *(float*)(OPS + (size_t)(hv * 128 + ch) * OPS_BLK + OP_GL) = __expf(g);
        }
        for (int i = tid; i < 2 * 64 * 128; i += 512) {
            const int which = i >> 13, tok = (i >> 7) & 63, c = i & 127;
            (which ? Kb : Qb)[tok * 136 + c] = f2bf((which ? SK : SQ)[(size_t)(t0 + tok) * 2048 + hq * 128 + c]);
        }
        __syncthreads();
      } else {
        if (tid < 128) {
            const int hvl = tid >> 6, hv = 2 * hq + hvl, tok = tid & 63;
            const float b = BA[(size_t)(t0 + tok) * 64 + hv], a = BA[(size_t)(t0 + tok) * 64 + 32 + hv];
            const float be = 1.f / (1.f + __expf(-b));
            const float xs = a + p.in[15][hv];
            const float sp = xs > 20.f ? xs : log1pf(__expf(xs));
            float g = -__expf(p.in[14][hv]) * sp;
#pragma unroll
            for (int o = 1; o < 64; o <<= 1) { const float t = __shfl_up(g, o); if (tok >= o) g += t; }
            beta[hvl * 64 + tok] = be; gc[hvl * 64 + tok] = g;
            if (tok == 63) *(float*)(OPS + (size_t)(hv * 128 + ch) * OPS_BLK + OP_GL) = __expf(g);
        }
        {
            const int cc = tid & 255, half = tid >> 8;
            const int col = cc < 128 ? hq * 128 + cc : 2048 + hq * 128 + (cc - 128);
            const float w0 = cw[col], w1 = cw[8192 + col], w2 = cw[2 * 8192 + col], w3 = cw[3 * 8192 + col];
            const int ts = t0 + 32 * half;
            u16 xr[35];
#pragma unroll
            for (int t = 0; t < 35; ++t) { const int tt = ts - 3 + t; xr[t] = PQ[(size_t)(tt < 0 ? 0 : tt) * 8192 + col]; }
            LAS float* X = cc < 128 ? Xq : Xk; const int c7 = cc & 127;
            float x0 = ts >= 3 ? bf2f(xr[0]) : 0.f, x1 = ts >= 3 ? bf2f(xr[1]) : 0.f, x2 = ts >= 3 ? bf2f(xr[2]) : 0.f;
#pragma unroll
            for (int t = 0; t < 32; ++t) {
                const float x3 = bf2f(xr[t + 3]);
                const float y = w0 * x0 + w1 * x1 + w2 * x2 + w3 * x3;
                X[(32 * half + t) * 129 + c7] = silu_f(y); x0 = x1; x1 = x2; x2 = x3;
            }
        }
        __syncthreads();
        {
            const int idx = tid >> 2, pq = tid & 3, which = idx >> 6, tok = idx & 63; const LAS float* X = (which ? Xk : Xq) + tok * 129 + pq; float s = 0.f;
#pragma unroll 8
            for (int c = 0; c < 128; c += 4) s += X[c] * X[c];
            s += dpp_f<0xB1>(s); s += dpp_f<0x4E>(s);
            if (pq == 0) rsq[idx] = __builtin_amdgcn_rsqf(s + EPS) * (which ? 1.f : 0.08838834764831845f);
        }
        __syncthreads();
        for (int i = tid; i < 2 * 64 * 128; i += 512) {
            const int which = i >> 13, tok = (i >> 7) & 63, c = i & 127;
            const float v = (which ? Xk : Xq)[tok * 129 + c] * rsq[which * 64 + tok];
            (which ? Kb : Qb)[tok * 136 + c] = f2bf(v);
        }
        __syncthreads();
      }
        {
            const int ti = (wave >> 1) & 1, tj = wave & 1; v16f c = {};
            c = mm_tile(c, (wave < 4 ? Kb : Qb) + 32 * ti * 136, 136, Kb + 32 * tj * 136, 136, 128, lane);
            LAS float* D = wave < 4 ? KKf : QKf;
#pragma unroll
            for (int r = 0; r < 16; ++r) D[(32 * ti + crow(r, hi)) * 65 + 32 * tj + n] = c[r];
        }
        __syncthreads();
      if constexpr (FROM_S) {
        for (int hvl = 0; hvl < 2; ++hvl) {
            const int hv = 2 * hq + hvl;
            const LAS float* be = beta + hvl * 64; const LAS float* g = gc + hvl * 64;
            unsigned char* ob = OPS + (size_t)(hv * 128 + ch) * OPS_BLK;
            if constexpr (FROM_S) {
                for (int i = tid; i < 64 * 128; i += 512) { const int tok = i >> 7, c = i & 127; VbT[c * 72 + tok] = f2bf(SV[(size_t)(t0 + tok) * 4096 + hv * 128 + c]); }
            } else {
                const int c = tid & 127, q4 = tid >> 7, col = 4096 + hv * 128 + c;
                const float w0 = cw[col], w1 = cw[8192 + col], w2 = cw[2 * 8192 + col], w3 = cw[3 * 8192 + col];
                const int ts = t0 + 16 * q4;
                u16 xr[19];
#pragma unroll
                for (int t = 0; t < 19; ++t) { const int tt = ts - 3 + t; xr[t] = PQ[(size_t)(tt < 0 ? 0 : tt) * 8192 + col]; }
                float x0 = ts >= 3 ? bf2f(xr[0]) : 0.f, x1 = ts >= 3 ? bf2f(xr[1]) : 0.f, x2 = ts >= 3 ? bf2f(xr[2]) : 0.f;
#pragma unroll
                for (int t = 0; t < 16; ++t) {
                    const float x3 = bf2f(xr[t + 3]);
                    const float y = w0 * x0 + w1 * x1 + w2 * x2 + w3 * x3; const int tok = 16 * q4 + t;
                    VbT[c * 72 + tok] = f2bf(be[tok] * silu_f(y)); x0 = x1; x1 = x2; x2 = x3;
                }
            }
            for (int i = tid; i < 128 * 64; i += 512) { const int d = i >> 6, tok = i & 63; KbeT[d * 72 + tok] = f2bf(bf2f(Kb[tok * 136 + d]) * be[tok] * __expf(g[tok])); }
            for (int e = tid; e < 64 * 64; e += 512) {
                const int i = e >> 6, j = e & 63;
                Lf[i * 64 + j] = j < i ? be[i] * KKf[i * 65 + j] * __expf(g[i] - g[j]) : 0.f;
            }
            __syncthreads();
            if (wave == 0) {
                float tc[64];
                int lane_o = lane; asm volatile("" : "+v"(lane_o));
                unsigned lbase = (unsigned)(uintptr_t)Lf; asm volatile("" : "+v"(lbase));
                const LAS float* Lp = (const LAS float*)(uintptr_t)lbase;
                float Lr[64];
#pragma unroll
                for (int i = 0; i < 64; ++i) Lr[i] = Lp[i * 64 + lane_o];
#pragma unroll
                for (int i = 0; i < 64; ++i) {
                    float acc = (lane_o == i) ? 1.f : 0.f;
#pragma unroll
                    for (int j = 0; j < i; ++j) acc -= __int_as_float(__builtin_amdgcn_readlane(__float_as_int(Lr[i]), j)) * tc[j];
                    tc[i] = acc;
                }
#pragma unroll
                for (int i = 0; i < 64; ++i) Tb[i * 72 + lane] = f2bf(tc[i]);
            }
#if MK_CHECK == 2
            __syncthreads();
            if (wave == 1) { LAS u16* Ib = (LAS u16*)Lf; for (int i = 0; i < 64; ++i) Ib[i * 72 + lane] = (lane == i) ? (u16)0x3f80 : (u16)0; }
#endif
            __syncthreads();
            {
                const int mt = wave >> 2, nt = wave & 3; v16f c = {};
#if MK_CHECK == 2
                c = mm_tile(c, (LAS u16*)Lf + 32 * mt * 72, 72, VbT + 32 * nt * 72, 72, 64, lane);
#else
                c = mm_tile(c, Tb + 32 * mt * 72, 72, VbT + 32 * nt * 72, 72, 64, lane);
#endif
                v8s lo = pack8f(c[0], c[1], c[2], c[3], c[4], c[5], c[6], c[7]), hi8 = pack8f(c[8], c[9], c[10], c[11], c[12], c[13], c[14], c[15]);
                unsigned char* d = ob + OP_U + nt * 4096 + (mt * 64 + lane) * 32;
                *(v8s*)d = lo; *(v8s*)(d + 16) = hi8;
            }
            {
                const int t = wave >> 1, mt = wave & 1; v16f c = {};
                c = mm_tile(c, KbeT + 32 * t * 72, 72, Tb + 32 * mt * 72, 72, 64, lane);
                v8s lo = pack8f(-c[0], -c[1], -c[2], -c[3], -c[4], -c[5], -c[6], -c[7]), hi8 = pack8f(-c[8], -c[9], -c[10], -c[11], -c[12], -c[13], -c[14], -c[15]);
                *(v8s*)(ob + OP_W + (mt * 8 + 2 * t) * 1024 + lane * 16) = lo;
                *(v8s*)(ob + OP_W + (mt * 8 + 2 * t + 1) * 1024 + lane * 16) = hi8;
            }
            for (int task = tid; task < 1024; task += 512) {
                const int f = task >> 6, l = task & 63, m = l & 31, h2 = l >> 5, mi = f >> 3, ks = f & 7;
                const int tok = 32 * mi + m, d0 = 16 * ks + 4 * h2; const float eg = __expf(g[tok]);
                const LAS u16* q = Qb + tok * 136 + d0;
                *(v8s*)(ob + OP_QD + f * 1024 + l * 16) = pack8f(bf2f(q[0]) * eg, bf2f(q[1]) * eg, bf2f(q[2]) * eg, bf2f(q[3]) * eg, bf2f(q[8]) * eg, bf2f(q[9]) * eg, bf2f(q[10]) * eg, bf2f(q[11]) * eg);
            }
            {
                const float g63 = g[63];
                for (int task = tid; task < 1024; task += 512) {
                    const int f = task >> 6, l = task & 63, m = l & 31, h2 = l >> 5, t = f >> 2, ks = f & 3;
                    const int tk0 = 16 * ks + 4 * h2, d = 32 * t + m; float v[8];
#pragma unroll
                    for (int j = 0; j < 8; ++j) { const int tok = tk0 + (j & 3) + 8 * (j >> 2); v[j] = bf2f(Kb[tok * 136 + d]) * __expf(g63 - g[tok]); }
                    *(v8s*)(ob + OP_KD + f * 1024 + l * 16) = pack8f(v[0], v[1], v[2], v[3], v[4], v[5], v[6], v[7]);
                }
            }
            {
                const int f = tid >> 6, l = tid & 63, m = l & 31, h2 = l >> 5, mi = f >> 2, ks = f & 3;
                const int i = 32 * mi + m, tk0 = 16 * ks + 4 * h2; const float gi = g[i]; float v[8];
#pragma unroll
                for (int j = 0; j < 8; ++j) { const int tok = tk0 + (j & 3) + 8 * (j >> 2); v[j] = tok <= i ? QKf[i * 65 + tok] * __expf(gi - g[tok]) : 0.f; }
                *(v8s*)(ob + OP_QK + f * 1024 + l * 16) = pack8f(v[0], v[1], v[2], v[3], v[4], v[5], v[6], v[7]);
            }
            __syncthreads();
        }
      } else {
#define P2_FILL_L(Ld_, hvl_) do { const LAS float* be_ = beta + (hvl_) * 64; const LAS float* g_ = gc + (hvl_) * 64; \
            for (int e = tid; e < 64 * 64; e += 512) { const int i = e >> 6, j = e & 63; (Ld_)[i * 64 + j] = j < i ? be_[i] * KKf[i * 65 + j] * __expf(g_[i] - g_[j]) : 0.f; } } while (0)
#define P2_LOAD_L(Ls_) do { unsigned lb_ = (unsigned)(uintptr_t)(Ls_); asm volatile("" : "+v"(lb_)); const LAS float* Lp_ = (const LAS float*)(uintptr_t)lb_; \
            _Pragma("unroll") for (int i = 0; i < 64; ++i) Lr[i] = Lp_[i * 64 + lane]; } while (0)
#define P2_VCONV(hv_, be_, first_, step_) do { for (int it_ = (first_); it_ < 512; it_ += (step_)) { \
            const int c = it_ & 127, q4 = it_ >> 7, col = 4096 + (hv_) * 128 + c; \
            const float w0 = cw[col], w1 = cw[8192 + col], w2 = cw[2 * 8192 + col], w3 = cw[3 * 8192 + col]; \
            const int ts = t0 + 16 * q4; u16 xr[19]; \
            _Pragma("unroll") for (int t = 0; t < 19; ++t) { const int tt = ts - 3 + t; xr[t] = PQ[(size_t)(tt < 0 ? 0 : tt) * 8192 + col]; } \
            float x0 = ts >= 3 ? bf2f(xr[0]) : 0.f, x1 = ts >= 3 ? bf2f(xr[1]) : 0.f, x2 = ts >= 3 ? bf2f(xr[2]) : 0.f; \
            _Pragma("unroll") for (int t = 0; t < 16; ++t) { const float x3 = bf2f(xr[t + 3]); const float y = w0 * x0 + w1 * x1 + w2 * x2 + w3 * x3; const int tok = 16 * q4 + t; \
                VbT[c * 72 + tok] = f2bf((be_)[tok] * silu_f(y)); x0 = x1; x1 = x2; x2 = x3; } } } while (0)
#define P2_KBE(be_, g_, first_, step_) do { for (int i = (first_); i < 128 * 64; i += (step_)) { const int d = i >> 6, tok = i & 63; KbeT[d * 72 + tok] = f2bf(bf2f(Kb[tok * 136 + d]) * (be_)[tok] * __expf((g_)[tok])); } } while (0)
#define P2_TILES(Tp_, ob_) do { \
            { const int mt = wave >> 2, nt = wave & 3; v16f c = {}; c = mm_tile(c, (Tp_) + 32 * mt * 72, 72, VbT + 32 * nt * 72, 72, 64, lane); \
              v8s lo = pack8f(c[0], c[1], c[2], c[3], c[4], c[5], c[6], c[7]), hi8 = pack8f(c[8], c[9], c[10], c[11], c[12], c[13], c[14], c[15]); \
              unsigned char* d = (ob_) + OP_U + nt * 4096 + (mt * 64 + lane) * 32; *(v8s*)d = lo; *(v8s*)(d + 16) = hi8; } \
            { const int t = wave >> 1, mt = wave & 1; v16f c = {}; c = mm_tile(c, KbeT + 32 * t * 72, 72, (Tp_) + 32 * mt * 72, 72, 64, lane); \
              v8s lo = pack8f(-c[0], -c[1], -c[2], -c[3], -c[4], -c[5], -c[6], -c[7]), hi8 = pack8f(-c[8], -c[9], -c[10], -c[11], -c[12], -c[13], -c[14], -c[15]); \
              *(v8s*)((ob_) + OP_W + (mt * 8 + 2 * t) * 1024 + lane * 16) = lo; *(v8s*)((ob_) + OP_W + (mt * 8 + 2 * t + 1) * 1024 + lane * 16) = hi8; } } while (0)
        LAS u16* Tb1 = (LAS u16*)Lf;
        unsigned char* ob0 = OPS + (size_t)((2 * hq) * 128 + ch) * OPS_BLK; unsigned char* ob1 = ob0 + (size_t)128 * OPS_BLK;
        float Lr[64];
        LAS float* Lf1 = (LAS float*)(lds + PL_HD + 64512);
        P2_FILL_L(Lf, 0); P2_FILL_L(Lf1, 1); __syncthreads();
        if (wave == 0) P2_LOAD_L(Lf);
        if (wave == 1) P2_LOAD_L(Lf1);
        __syncthreads();
        if (wave < 2) {
            float tc[64];
            int lane_o = lane; asm volatile("" : "+v"(lane_o));
#pragma unroll
            for (int i = 0; i < 64; ++i) {
                float acc = (lane_o == i) ? 1.f : 0.f;
#pragma unroll
                for (int j = 0; j < i; ++j) acc -= __int_as_float(__builtin_amdgcn_readlane(__float_as_int(Lr[i]), j)) * tc[j];
                tc[i] = acc;
            }
            LAS u16* Tw = wave == 0 ? Tb : Tb1;
#pragma unroll
            for (int i = 0; i < 64; ++i) Tw[i * 72 + lane] = f2bf(tc[i]);
        } else {
            const int t2 = tid - 128;
            for (int hvl = 0; hvl < 2; ++hvl) {
                const LAS float* g = gc + hvl * 64; unsigned char* ob = hvl ? ob1 : ob0;
                for (int task = t2; task < 1024; task += 384) {
                    const int f = task >> 6, l = task & 63, m = l & 31, h2 = l >> 5, mi = f >> 3, ks = f & 7;
                    const int tok = 32 * mi + m, d0 = 16 * ks + 4 * h2; const float eg = __expf(g[tok]);
                    const LAS u16* q = Qb + tok * 136 + d0;
                    *(v8s*)(ob + OP_QD + f * 1024 + l * 16) = pack8f(bf2f(q[0]) * eg, bf2f(q[1]) * eg, bf2f(q[2]) * eg, bf2f(q[3]) * eg, bf2f(q[8]) * eg, bf2f(q[9]) * eg, bf2f(q[10]) * eg, bf2f(q[11]) * eg);
                }
                const float g63 = g[63];
                for (int task = t2; task < 1024; task += 384) {
                    const int f = task >> 6, l = task & 63, m = l & 31, h2 = l >> 5, t = f >> 2, ks = f & 3;
                    const int tk0 = 16 * ks + 4 * h2, d = 32 * t + m; float v[8];
#pragma unroll
                    for (int j = 0; j < 8; ++j) { const int tok = tk0 + (j & 3) + 8 * (j >> 2); v[j] = bf2f(Kb[tok * 136 + d]) * __expf(g63 - g[tok]); }
                    *(v8s*)(ob + OP_KD + f * 1024 + l * 16) = pack8f(v[0], v[1], v[2], v[3], v[4], v[5], v[6], v[7]);
                }
                for (int task = t2; task < 512; task += 384) {
                    const int f = task >> 6, l = task & 63, m = l & 31, h2 = l >> 5, mi = f >> 2, ks = f & 3;
                    const int i = 32 * mi + m, tk0 = 16 * ks + 4 * h2; const float gi = g[i]; float v[8];
#pragma unroll
                    for (int j = 0; j < 8; ++j) { const int tok = tk0 + (j & 3) + 8 * (j >> 2); v[j] = tok <= i ? QKf[i * 65 + tok] * __expf(gi - g[tok]) : 0.f; }
                    *(v8s*)(ob + OP_QK + f * 1024 + l * 16) = pack8f(v[0], v[1], v[2], v[3], v[4], v[5], v[6], v[7]);
                }
            }
            P2_VCONV(2 * hq, beta, t2, 384);
            P2_KBE(beta, gc, t2, 384);
        }
        __syncthreads();
        P2_TILES(Tb, ob0);
        __syncthreads();
        P2_VCONV(2 * hq + 1, beta + 64, tid, 512);
        P2_KBE(beta + 64, gc + 64, tid, 512);
        __syncthreads();
        P2_TILES(Tb1, ob1);
#undef P2_FILL_L
#undef P2_LOAD_L
#undef P2_VCONV
#undef P2_KBE
#undef P2_TILES
      }
    }
}

template <bool HYB, int HV_LIM> __device__ __forceinline__ void phase_gdn_scan(const Params& p, LAS unsigned char* lds) {
    volatile LAS int* fl = (volatile LAS int*)(lds + 2 * SCAN_BUF);
    if (otid() == 0) { fl[0] = 0; fl[1] = 0; }
    __syncthreads();
    if (otid() >= 128 || (blockIdx.x >> 3) >= 16) return;
    const int lane = otid() & 63, role = __builtin_amdgcn_readfirstlane((int)otid() >> 6), hv = (blockIdx.x & 7) * 4 + (blockIdx.x >> 5), nt = (blockIdx.x >> 3) & 3, n = lane & 31, hi = lane >> 5;
    if (hv >= HV_LIM) return;
    const unsigned char* src0 = p.ws + (HYB ? WS_OPS_H : WS_OPS) + (size_t)hv * 128 * OPS_BLK;
    float* og = (float*)(p.ws + WS_OG);
    v16f St[4];
#pragma unroll
    for (int t = 0; t < 4; ++t)
#pragma unroll
        for (int r = 0; r < 16; ++r) St[t][r] = 0.f;
#define SCAN_ISSUE(c_, buf_) do { const unsigned char* s_ = src0 + (size_t)(c_) * OPS_BLK + lane * 16; LAS unsigned char* d_ = lds + (buf_) * SCAN_BUF; \
        _Pragma("unroll") for (int i_ = 0; i_ < 56; ++i_) __builtin_amdgcn_global_load_lds((const unsigned*)(s_ + i_ * 1024), (LAS unsigned*)(d_ + i_ * 1024), 16, 0, 0); \
        _Pragma("unroll") for (int i_ = 0; i_ < 4; ++i_) __builtin_amdgcn_global_load_lds((const unsigned*)(s_ + OP_U + nt * 4096 + i_ * 1024), (LAS unsigned*)(d_ + OP_U + i_ * 1024), 16, 0, 0); } while (0)
    if (role == 1) {
        for (int c = 0; c < 128; ++c) {
            if (c >= 2) { while (fl[1] < c - 1) __builtin_amdgcn_s_sleep(1); }
            asm volatile("" ::: "memory");
            SCAN_ISSUE(c, c & 1);
            VM_WAIT();
            if (lane == 0) fl[0] = c + 1;
        }
        return;
    }
    const int gl_lo = __float_as_int(*(const float*)(src0 + (size_t)lane * OPS_BLK + OP_GL)), gl_hi = __float_as_int(*(const float*)(src0 + (size_t)(lane + 64) * OPS_BLK + OP_GL));
#define SB_() __builtin_amdgcn_sched_barrier(0)
#define FR_(off) (*(const LAS v8s*)(B + (off) + lane * 16))
#define LD_W(f, k0)  do { _Pragma("unroll") for (int q_ = 0; q_ < 8; ++q_) f[q_] = FR_(OP_W + ((q_ & 1) * 8 + (k0) + (q_ >> 1)) * 1024); } while (0)
#define LD_QD(f, k0) do { _Pragma("unroll") for (int q_ = 0; q_ < 8; ++q_) f[q_] = FR_(OP_QD + ((q_ & 1) * 8 + (k0) + (q_ >> 1)) * 1024); } while (0)
#define LD_QK(f)     do { _Pragma("unroll") for (int q_ = 0; q_ < 8; ++q_) f[q_] = FR_(OP_QK + ((q_ & 1) * 4 + (q_ >> 1)) * 1024); } while (0)
#define LD_KD(f, k0) do { _Pragma("unroll") for (int q_ = 0; q_ < 8; ++q_) f[q_] = FR_(OP_KD + ((q_ & 3) * 4 + (k0) + (q_ >> 2)) * 1024); } while (0)
    for (int c = 0; c < 128; ++c) {
        const int buf = c & 1;
        while (fl[0] < c + 1) __builtin_amdgcn_s_sleep(1);
        asm volatile("" ::: "memory");
        const LAS unsigned char* B = lds + buf * SCAN_BUF;
        const float gl = __int_as_float(__builtin_amdgcn_readlane(c < 64 ? gl_lo : gl_hi, c & 63));
        v8s fa[8], fb[8];
        LD_W(fa, 0);
        v8s Sb[8];
#pragma unroll
        for (int t = 0; t < 4; ++t) {
            Sb[2 * t] = pack8f(St[t][0], St[t][1], St[t][2], St[t][3], St[t][4], St[t][5], St[t][6], St[t][7]);
            Sb[2 * t + 1] = pack8f(St[t][8], St[t][9], St[t][10], St[t][11], St[t][12], St[t][13], St[t][14], St[t][15]);
#pragma unroll
            for (int r = 0; r < 16; ++r) St[t][r] *= gl;
        }
        v16f Vn[2], O2[2];
#pragma unroll
        for (int mt = 0; mt < 2; ++mt) {
            const v4u u0 = *(const LAS v4u*)(B + OP_U + (mt * 64 + lane) * 32), u1 = *(const LAS v4u*)(B + OP_U + (mt * 64 + lane) * 32 + 16);
            Vn[mt][0] = bflo(u0.x); Vn[mt][1] = bfhi(u0.x); Vn[mt][2] = bflo(u0.y); Vn[mt][3] = bfhi(u0.y); Vn[mt][4] = bflo(u0.z); Vn[mt][5] = bfhi(u0.z); Vn[mt][6] = bflo(u0.w); Vn[mt][7] = bfhi(u0.w);
            Vn[mt][8] = bflo(u1.x); Vn[mt][9] = bfhi(u1.x); Vn[mt][10] = bflo(u1.y); Vn[mt][11] = bfhi(u1.y); Vn[mt][12] = bflo(u1.z); Vn[mt][13] = bfhi(u1.z); Vn[mt][14] = bflo(u1.w); Vn[mt][15] = bfhi(u1.w);
#pragma unroll
            for (int r = 0; r < 16; ++r) O2[mt][r] = 0.f;
        }
        SB_(); LD_W(fb, 4); SB_();
#pragma unroll
        for (int q = 0; q < 8; ++q) Vn[q & 1] = __builtin_amdgcn_mfma_f32_32x32x16_bf16(fa[q], Sb[q >> 1], Vn[q & 1], 0, 0, 0);
        SB_(); LD_QD(fa, 0); SB_();
#pragma unroll
        for (int q = 0; q < 8; ++q) Vn[q & 1] = __builtin_amdgcn_mfma_f32_32x32x16_bf16(fb[q], Sb[4 + (q >> 1)], Vn[q & 1], 0, 0, 0);
        SB_(); LD_QD(fb, 4); SB_();
#pragma unroll
        for (int q = 0; q < 8; ++q) O2[q & 1] = __builtin_amdgcn_mfma_f32_32x32x16_bf16(fa[q], Sb[q >> 1], O2[q & 1], 0, 0, 0);
        SB_(); LD_QK(fa); SB_();
#pragma unroll
        for (int q = 0; q < 8; ++q) O2[q & 1] = __builtin_amdgcn_mfma_f32_32x32x16_bf16(fb[q], Sb[4 + (q >> 1)], O2[q & 1], 0, 0, 0);
        v8s Vb[4];
#pragma unroll
        for (int mt = 0; mt < 2; ++mt) {
            Vb[2 * mt] = pack8f(Vn[mt][0], Vn[mt][1], Vn[mt][2], Vn[mt][3], Vn[mt][4], Vn[mt][5], Vn[mt][6], Vn[mt][7]);
            Vb[2 * mt + 1] = pack8f(Vn[mt][8], Vn[mt][9], Vn[mt][10], Vn[mt][11], Vn[mt][12], Vn[mt][13], Vn[mt][14], Vn[mt][15]);
        }
        SB_(); LD_KD(fb, 0); SB_();
#pragma unroll
        for (int q = 0; q < 8; ++q) O2[q & 1] = __builtin_amdgcn_mfma_f32_32x32x16_bf16(fa[q], Vb[q >> 1], O2[q & 1], 0, 0, 0);
        SB_(); LD_KD(fa, 2); SB_();
#pragma unroll
        for (int q = 0; q < 8; ++q) St[q & 3] = __builtin_amdgcn_mfma_f32_32x32x16_bf16(fb[q], Vb[q >> 2], St[q & 3], 0, 0, 0);
        SB_();
#pragma unroll
        for (int q = 0; q < 8; ++q) St[q & 3] = __builtin_amdgcn_mfma_f32_32x32x16_bf16(fa[q], Vb[2 + (q >> 2)], St[q & 3], 0, 0, 0);
        LDS_WAIT(); if (lane == 0) fl[1] = c + 1;
#pragma unroll
        for (int mi = 0; mi < 2; ++mi)
#pragma unroll
            for (int r = 0; r < 16; ++r) og[(size_t)(c * 64 + 32 * mi + crow(r, hi)) * GV + hv * 128 + nt * 32 + n] = O2[mi][r];
    }
#undef SB_
#undef FR_
#undef LD_W
#undef LD_QD
#undef LD_QK
#undef LD_KD
#undef SCAN_ISSUE
}

__device__ __forceinline__ float conv4_at(const u16* PQ, const float* cw, int t, int col) {
    float y = 0.f;
#pragma unroll
    for (int j = 0; j < 4; ++j) { const int tt = t - 3 + j; const float w = tt >= 0 ? cw[j * 8192 + col] : 0.f; y += w * bf2f(PQ[(size_t)(tt < 0 ? 0 : tt) * 8192 + col]); }
    return silu_f(y);
}
__device__ __forceinline__ void phase_gdn_prep_simple(const Params& p) {
    const int tid = otid(), lane = tid & 63, wave = tid >> 6;
    const int gw = blockIdx.x * 8 + wave, NGW = gridDim.x * 8;
    const u16* PQ = (const u16*)(p.ws + WS_PQKV); const float* BA = (const float*)(p.ws + WS_BA); const float* cw = p.in[13];
    float* SQ = (float*)(p.ws + WS_SQ); float* SK = (float*)(p.ws + WS_SK); float* SV = (float*)(p.ws + WS_SV); float* SG = (float*)(p.ws + WS_SG);
    for (int it = gw; it < S_ * 16; it += NGW) {
        const int t = it >> 4, hq = it & 15;
        const int c0 = 2 * lane;
        const float q0 = conv4_at(PQ, cw, t, hq * 128 + c0), q1 = conv4_at(PQ, cw, t, hq * 128 + c0 + 1);
        const float k0 = conv4_at(PQ, cw, t, 2048 + hq * 128 + c0), k1 = conv4_at(PQ, cw, t, 2048 + hq * 128 + c0 + 1);
        const float rq = __builtin_amdgcn_rsqf(wave_sum(q0 * q0 + q1 * q1) + EPS) * 0.08838834764831845f;
        const float rk = __builtin_amdgcn_rsqf(wave_sum(k0 * k0 + k1 * k1) + EPS);
        SQ[(size_t)t * 2048 + hq * 128 + c0] = q0 * rq; SQ[(size_t)t * 2048 + hq * 128 + c0 + 1] = q1 * rq;
        SK[(size_t)t * 2048 + hq * 128 + c0] = k0 * rk; SK[(size_t)t * 2048 + hq * 128 + c0 + 1] = k1 * rk;
#pragma unroll
        for (int hvl = 0; hvl < 2; ++hvl) {
            const int hv = 2 * hq + hvl;
            const float be = 1.f / (1.f + __expf(-BA[(size_t)t * 64 + hv]));
            const float v0 = conv4_at(PQ, cw, t, 4096 + hv * 128 + c0), v1 = conv4_at(PQ, cw, t, 4096 + hv * 128 + c0 + 1);
            SV[(size_t)t * 4096 + hv * 128 + c0] = be * v0; SV[(size_t)t * 4096 + hv * 128 + c0 + 1] = be * v1;
            if (lane == 0) {
                const float xs = BA[(size_t)t * 64 + 32 + hv] + p.in[15][hv];
                const float sp = xs > 20.f ? xs : log1pf(__expf(xs));
                SG[((size_t)t * 32 + hv) * 2] = -__expf(p.in[14][hv]) * sp; SG[((size_t)t * 32 + hv) * 2 + 1] = be;
            }
        }
    }
}
__device__ __forceinline__ void phase_gdn_scan_simple(const Params& p, LAS unsigned char* lds) {
    const int tid = otid(), xcd = blockIdx.x & 7, slot = blockIdx.x >> 3;
    if (slot >= 32) return;
    const int hv = xcd * 4 + (slot >> 3), hq = hv >> 1, cb = 16 * (slot & 7);
    const float* SQ = (const float*)(p.ws + WS_SQ); const float* SK = (const float*)(p.ws + WS_SK); const float* SV = (const float*)(p.ws + WS_SV); const float* SG = (const float*)(p.ws + WS_SG);
    float* og = (float*)(p.ws + WS_OG);
    LAS float* kq = (LAS float*)lds;
    LAS float* gb = kq + 64 * 256;
    LAS float* vb = gb + 128;
    LAS float* ob = vb + 64 * 16;
    float St[8];
#pragma unroll
    for (int d = 0; d < 8; ++d) St[d] = 0.f;
    const int el = (tid >> 4) & 15, h = tid & 15;
    v4f rk[4], rq[4], rv; float rg = 0.f;
#define SS_LOAD(c_) do { \
        _Pragma("unroll") for (int k_ = 0; k_ < 4; ++k_) { const int i_ = tid + 512 * k_, tok_ = i_ >> 5, d4_ = i_ & 31; const size_t g_ = (size_t)((c_) * 64 + tok_) * 2048 + hq * 128 + 4 * d4_; rk[k_] = *(const v4f*)(SK + g_); rq[k_] = *(const v4f*)(SQ + g_); } \
        if (tid < 256) rv = *(const v4f*)(SV + (size_t)((c_) * 64 + (tid >> 2)) * 4096 + hv * 128 + cb + 4 * (tid & 3)); \
        if (tid < 128) rg = SG[((size_t)((c_) * 64 + (tid >> 1)) * 32 + hv) * 2 + (tid & 1)]; } while (0)
    SS_LOAD(0);
    for (int c = 0; c < 128; ++c) {
        __syncthreads();
#pragma unroll
        for (int k = 0; k < 4; ++k) { const int i = tid + 512 * k, tok = i >> 5, d4 = i & 31; *(LAS v4f*)(kq + tok * 256 + 4 * d4) = rk[k]; *(LAS v4f*)(kq + tok * 256 + 128 + 4 * d4) = rq[k]; }
        if (tid < 256) *(LAS v4f*)(vb + 4 * tid) = rv;
        if (tid < 128) { const float ex = __expf(__shfl(rg, (tid & 62), 64)); gb[tid] = (tid & 1) ? rg * ex : ex; }
        __syncthreads();
        if (c + 1 < 128) SS_LOAD(c + 1);
        if (tid < 256) {
            for (int tok0 = 0; tok0 < 64; tok0 += 8) {
                float o8[8];
#pragma unroll
                for (int u = 0; u < 8; ++u) {
                    const int tok = tok0 + u;
                    const float dec = gb[2 * tok], bd = gb[2 * tok + 1];
                    const float bv = vb[tok * 16 + el];
                    const LAS float* kk = kq + tok * 256 + 8 * h; const LAS float* qq = kk + 128;
                    float ks0 = 0.f, ks1 = 0.f;
#pragma unroll
                    for (int d = 0; d < 8; d += 2) { ks0 += kk[d] * St[d]; ks1 += kk[d + 1] * St[d + 1]; }
                    float ks = ks0 + ks1;
                    ks += dpp_f<0xB1>(ks); ks += dpp_f<0x4E>(ks); ks += dpp_f<0x141>(ks); ks += dpp_f<0x140>(ks);
                    const float delta = bv - bd * ks;
                    float o0 = 0.f, o1 = 0.f;
#pragma unroll
                    for (int d = 0; d < 8; d += 2) {
                        St[d] = dec * St[d] + kk[d] * delta; o0 += qq[d] * St[d];
                        St[d + 1] = dec * St[d + 1] + kk[d + 1] * delta; o1 += qq[d + 1] * St[d + 1]; }
                    float o = o0 + o1;
                    o += dpp_f<0xB1>(o); o += dpp_f<0x4E>(o); o += dpp_f<0x141>(o); o += dpp_f<0x140>(o);
                    o8[u] = o;
                }
                if (h == 0) {
#pragma unroll
                    for (int u = 0; u < 8; ++u) ob[(tok0 + u) * 16 + el] = o8[u];
                }
            }
        }
        __syncthreads();
        if (tid < 256) *(v4f*)(og + (size_t)(c * 64 + (tid >> 2)) * GV + hv * 128 + cb + 4 * (tid & 3)) = *(const LAS v4f*)(ob + 4 * tid);
    }
#undef SS_LOAD
}

__device__ __forceinline__ void frag_pos(int row, int kk, int& lane, int& j) {
    const int h2 = (kk >> 2) & 1; j = (kk & 3) + 4 * (kk >> 3); lane = row + 32 * h2; }
template <int HQ_LIM> __device__ __forceinline__ void phase_gdn_check(const Params& p, LAS unsigned char* lds) {
    const int tid = otid();
    const float* SQ = (const float*)(p.ws + WS_SQ); const float* SK = (const float*)(p.ws + WS_SK); const float* SV = (const float*)(p.ws + WS_SV); const float* SG = (const float*)(p.ws + WS_SG);
    const unsigned char* OPS = p.ws + WS_OPS_H; unsigned* flags = (unsigned*)(p.ws + WS_MISC);
    LAS float* Kf = (LAS float*)lds; LAS float* Qf = Kf + 64 * 129; LAS float* Vf = Qf + 64 * 129; LAS float* Tf = Vf + 64 * 129; LAS float* Lx = Tf + 64 * 65; LAS float* gcs = Lx + 64 * 65; LAS float* bes = gcs + 64;
    for (int item = blockIdx.x; item < 2 * HQ_LIM * 128; item += gridDim.x) {
        const int hv = item >> 7, ch = item & 127, hq = hv >> 1, t0 = ch * 64;
        __syncthreads();
        for (int i = tid; i < 64 * 128; i += 512) { const int tok = i >> 7, c = i & 127;
            Kf[tok * 129 + c] = bf2f(f2bf(SK[(size_t)(t0 + tok) * 2048 + hq * 128 + c])); Qf[tok * 129 + c] = bf2f(f2bf(SQ[(size_t)(t0 + tok) * 2048 + hq * 128 + c]));
            Vf[tok * 129 + c] = bf2f(f2bf(SV[(size_t)(t0 + tok) * 4096 + hv * 128 + c])); }
        if (tid == 0) { float a = 0.f; for (int t = 0; t < 64; ++t) { a += SG[((size_t)(t0 + t) * 32 + hv) * 2]; gcs[t] = a; bes[t] = SG[((size_t)(t0 + t) * 32 + hv) * 2 + 1]; } }
        __syncthreads();
        for (int e = tid; e < 4096; e += 512) { const int i = e >> 6, j = e & 63; float v = 0.f;
            if (j < i) { float d = 0.f; for (int c = 0; c < 128; ++c) d += Kf[i * 129 + c] * Kf[j * 129 + c]; v = bes[i] * d * __expf(gcs[i] - gcs[j]); }
            Lx[i * 65 + j] = v; }
        __syncthreads();
        if (tid < 64) { for (int i = 0; i < 64; ++i) { float acc = (tid == i) ? 1.f : 0.f; for (int j = 0; j < i; ++j) acc -= Lx[i * 65 + j] * Tf[j * 65 + tid]; Tf[i * 65 + tid] = acc; } }
        __syncthreads();
        const unsigned char* ob = OPS + (size_t)(hv * 128 + ch) * OPS_BLK;
        unsigned bad = 0u;
        const int i = tid & 63, e = ((tid >> 6) * 17 + ch * 5 + hv) & 127, tau = e & 63;
#define CHK(bit, got, ex) do { const float g_ = (got), x_ = (ex); if (!(__builtin_fabsf(g_ - x_) <= 0.03f * __builtin_fabsf(x_) + 0.03f)) bad |= (bit); } while (0)
        { float u = 0.f, w = 0.f; for (int j = 0; j < 64; ++j) { const float t = Tf[i * 65 + j]; u += (MK_CHECK == 2 ? (j == i ? 1.f : 0.f) : t) * Vf[j * 129 + e]; w += t * Kf[j * 129 + e] * bes[j] * __expf(gcs[j]); }
          { const int ii = i & 31, hi = (ii >> 2) & 1, r = (ii & 3) + 4 * (ii >> 3), lane = (e & 31) + 32 * hi;
            const float got = bf2f(*(const u16*)(ob + OP_U + (e >> 5) * 4096 + ((i >> 5) * 64 + lane) * 32 + r * 2));
            if (!(__builtin_fabsf(got - u) <= 0.1f * __builtin_fabsf(u) + 0.5f)) bad |= 1u | ((i >> 5) ? 2u : 0u) | (((e >> 5) & 1) ? 4u : 0u) | ((e >> 6) ? 8u : 0u) | (r >= 8 ? 16u : 0u) | (hi ? 32u : 0u); }
          { int lane, j; frag_pos(i & 31, e & 15, lane, j); CHK(0u, bf2f(*(const u16*)(ob + OP_W + ((i >> 5) * 8 + (e >> 4)) * 1024 + lane * 16 + j * 2)), -w);
            CHK(0u, bf2f(*(const u16*)(ob + OP_QD + ((i >> 5) * 8 + (e >> 4)) * 1024 + lane * 16 + j * 2)), Qf[i * 129 + e] * __expf(gcs[i])); } }
        { int lane, j; frag_pos(e & 31, i & 15, lane, j);
          CHK(0u, bf2f(*(const u16*)(ob + OP_KD + ((e >> 5) * 4 + (i >> 4)) * 1024 + lane * 16 + j * 2)), Kf[i * 129 + e] * __expf(gcs[63] - gcs[i])); }
        { int lane, j; frag_pos(i & 31, tau & 15, lane, j); float d = 0.f; for (int c = 0; c < 128; ++c) d += Qf[i * 129 + c] * Kf[tau * 129 + c];
          CHK(0u, bf2f(*(const u16*)(ob + OP_QK + ((i >> 5) * 4 + (tau >> 4)) * 1024 + lane * 16 + j * 2)), tau <= i ? d * __expf(gcs[i] - gcs[tau]) : 0.f); }
        if (tid == 0) CHK(0u, *(const float*)(ob + OP_GL), __expf(gcs[63]));
#undef CHK
        if (bad) atomicOr(flags, bad);
    }
}
__device__ __forceinline__ void phase_gdn_post(const Params& p) {
    const int tid = otid(), lane = tid & 63, wave = tid >> 6;
    const int gw = blockIdx.x * 8 + wave, NGW = gridDim.x * 8;
    const float* og = (const float*)(p.ws + WS_OG); const u16* Z = (const u16*)(p.ws + WS_Z); u16* out = (u16*)(p.ws + WS_OGN);
    const int e0 = 4 * (lane & 31); const v4f gn = *(const v4f*)(p.in[16] + e0);
    for (int it0 = gw * 4; it0 < S_ * 16; it0 += NGW * 4) {
        v4f ow[4]; v2u zw[4]; float ss[4];
#pragma unroll
        for (int u = 0; u < 4; ++u) { const int it = it0 + u, t = it >> 4, hv = 2 * (it & 15) + (lane >> 5); const size_t off = (size_t)t * GV + hv * 128 + e0;
            ow[u] = *(const v4f*)(og + off); zw[u] = *(const v2u*)(Z + off); }
#pragma unroll
        for (int u = 0; u < 4; ++u) ss[u] = (ow[u][0] * ow[u][0] + ow[u][1] * ow[u][1]) + (ow[u][2] * ow[u][2] + ow[u][3] * ow[u][3]);
#pragma unroll
        for (int o = 1; o < 32; o <<= 1) {
#pragma unroll
            for (int u = 0; u < 4; ++u) ss[u] += __shfl_xor(ss[u], o); }
#pragma unroll
        for (int u = 0; u < 4; ++u) { const int it = it0 + u, t = it >> 4, hv = 2 * (it & 15) + (lane >> 5); const size_t off = (size_t)t * GV + hv * 128 + e0;
            const float rs = __builtin_amdgcn_rsqf(ss[u] * (1.f / 128.f) + EPS);
            v2u w; w.x = cvtpk(ow[u][0] * rs * gn[0] * silu_f(bflo(zw[u].x)), ow[u][1] * rs * gn[1] * silu_f(bfhi(zw[u].x)));
            w.y = cvtpk(ow[u][2] * rs * gn[2] * silu_f(bflo(zw[u].y)), ow[u][3] * rs * gn[3] * silu_f(bfhi(zw[u].y)));
            *(v2u*)(out + off) = w; }
    }
}

#define XB_TMO      128
#define XB_XCNT(j)  (256  + 64 * (j))
#define XB_XSUB(j)  (1280 + 64 * (j))
#define XB_XGEN(j)  (2304 + 64 * (j))
#define XB_TOP      3328
#define XB_TOPGEN   3392
#define XCD_BAR_WORDS 3456
#define XB_SPIN_CAP (1u << 18)

__device__ __forceinline__ unsigned xb_ld(unsigned* p)              { return __hip_atomic_load(p, __ATOMIC_RELAXED, __HIP_MEMORY_SCOPE_AGENT); }
__device__ __forceinline__ unsigned xb_add(unsigned* p, unsigned v) { return __hip_atomic_fetch_add(p, v, __ATOMIC_RELAXED, __HIP_MEMORY_SCOPE_AGENT); }
__device__ __forceinline__ unsigned xb_xcc_id() { return (unsigned)__builtin_amdgcn_s_getreg((3 << 11) | 20) & 0xFu; }
#define XB_SPIN(cond, bar) do { unsigned _sp = 0; while (cond) { __builtin_amdgcn_s_sleep(1); \
    if ((++_sp & 255u) == 0u) { if (xb_ld(&(bar)[XB_TMO])) break; if (_sp > XB_SPIN_CAP) { atomicAdd(&(bar)[XB_TMO], 1u); break; } } } } while (0)

struct XcdBarrier {
    unsigned* bar; unsigned x;
    volatile LAS unsigned* st;
};

__device__ __forceinline__ XcdBarrier xcd_barrier_post(unsigned* bar, volatile LAS unsigned* st) {
    XcdBarrier b; b.bar = bar; b.x = xb_xcc_id(); b.st = st;
    if (otid() == 0) (void)xb_add(&bar[XB_XCNT(b.x)], 1u);
    return b;
}
__device__ __forceinline__ void xcd_barrier_complete(unsigned* bar, unsigned x, unsigned& nloc, unsigned& nx) {
    const unsigned G = gridDim.x * gridDim.y * gridDim.z;
    unsigned sum, cnt, mine, sp = 0u;
    for (;;) {
        sum = 0u; cnt = 0u; mine = 0u;
#pragma unroll
        for (unsigned j = 0; j < 16; ++j) { const unsigned c = xb_ld(&bar[XB_XCNT(j)]); sum += c; cnt += (c > 0u) ? 1u : 0u; mine = (j == x) ? c : mine; }
        if (sum == G) break;
        __builtin_amdgcn_s_sleep(1);
        if ((++sp & 255u) == 0u) { if (xb_ld(&bar[XB_TMO])) break; if (sp > XB_SPIN_CAP) { atomicAdd(&bar[XB_TMO], 1u); break; } }
    }
    nloc = mine > 0u ? mine : 1u; nx = cnt > 0u ? cnt : 1u;
}

__device__ __forceinline__ void xcd_barrier(const XcdBarrier& b) {
    asm volatile("s_waitcnt vmcnt(0)" ::: "memory");
    __syncthreads();
    if (otid() == 0) {
        unsigned* bar = b.bar;
        __builtin_amdgcn_s_waitcnt(0);
        unsigned nloc = b.st[0], nx = b.st[1];
        if (nloc == 0u) { xcd_barrier_complete(bar, b.x, nloc, nx); b.st[0] = nloc; b.st[1] = nx; }
        const unsigned old = xb_add(&bar[XB_XSUB(b.x)], 1u);
        const unsigned gen = old / nloc;
        if (old + 1u == (gen + 1u) * nloc) {
            __builtin_amdgcn_fence(__ATOMIC_RELEASE, "agent");
            asm volatile("s_waitcnt vmcnt(0)" ::: "memory");
            const unsigned og = xb_add(&bar[XB_TOP], 1u);
            const unsigned tg = og / nx;
            if (og + 1u == (tg + 1u) * nx) xb_add(&bar[XB_TOPGEN], 1u);
            else XB_SPIN(xb_ld(&bar[XB_TOPGEN]) == tg, bar);
            __builtin_amdgcn_fence(__ATOMIC_ACQUIRE, "agent");
            xb_add(&bar[XB_XGEN(b.x)], 1u);
            asm volatile("s_waitcnt vmcnt(0)" ::: "memory");
        } else {
            XB_SPIN(xb_ld(&bar[XB_XGEN(b.x)]) == gen, bar);
            __builtin_amdgcn_fence(__ATOMIC_ACQUIRE, "agent");
            asm volatile("s_waitcnt vmcnt(0)" ::: "memory");
        }
    }
    __syncthreads();
}

constexpr size_t WS_BAR = WS_MISC + 65536;
constexpr int LDS_BARST = LDS_BYTES - 16;

constexpr int NPHASE = 16;
template <int ph> __device__ __forceinline__ void run_phase(const Params& p, LAS unsigned char* lds, unsigned char* lds_raw) {
    unsigned char* ws = p.ws;
    float* ssq = (float*)(ws + WS_SSQ);
    u16* XB = (u16*)(ws + WS_XB);
    const int G = gridDim.x, c = blockIdx.x;
    switch (ph) {
    case 0: phase_p0(p, lds); break;
    case 1: { pg8::Gemm g{XB, (const u16*)(ws + WS_WQKV), S_, NQKV, DM}; pg8::StaticOrder S; S.init(S_, NQKV, G, c);
              EpiQKV E{(u16*)(ws + WS_QH)};
              pg8::gemm_phase<EpiQKV, pg8::StaticOrder>(lds, g, S, E, nullptr); } break;
    case 2: phase_attn(p, (char*)lds_raw); break;
    case 3: phase_combine(p); break;
    case 4: { pg8::Gemm g{(const u16*)(ws + WS_OB), (const u16*)(ws + WS_WO), S_, DM, DM}; pg8::StaticOrder S; S.init(S_, DM, G, c);
              EpiRes E{p.in[0], p.out, XB, ssq}; pg8::gemm_phase<EpiRes, pg8::StaticOrder>(lds, g, S, E, nullptr); } break;
    case 5: case 13: { const int l = ph == 13; pg8::Gemm g{XB, (const u16*)(ws + (l ? WS_WUP1 : WS_WUP0)), S_, NUP, DM}; pg8::StaticOrder S; S.init(S_, NUP, G, c);
              EpiScale E{ssq + (l ? 64 * S_ : 0), (u16*)(ws + WS_U), NUP, NUP, nullptr, 0, NUP, nullptr, 0, NUP};
              pg8::gemm_phase<EpiScale, pg8::StaticOrder>(lds, g, S, E, nullptr); } break;
    case 6: case 14: phase_convgate(p, ph == 14); break;
    case 7: case 15: { const int l = ph == 15; pg8::Gemm g{(const u16*)(ws + WS_Y), (const u16*)(ws + (l ? WS_WDN1 : WS_WDN0)), S_, DM, DFF}; pg8::StaticOrder S; S.init(S_, DM, G, c);
              EpiRes E{p.out, p.out, l ? nullptr : XB, l ? nullptr : ssq + 32 * S_}; pg8::gemm_phase<EpiRes, pg8::StaticOrder>(lds, g, S, E, nullptr); } break;
    case 8: { pg8::Gemm g{XB, (const u16*)(ws + WS_WIN), S_, 12288, DM}; pg8::StaticOrder S; S.init(S_, 12288, G, c);
              EpiScale E{ssq + 32 * S_, (u16*)(ws + WS_PQKV), 8192, 8192, (u16*)(ws + WS_Z), GV, 12288, nullptr, 0, 12288};
              pg8::gemm_phase<EpiScale, pg8::StaticOrder>(lds, g, S, E, nullptr);
              phase_ba(p, lds); } break;
#if MK_GDN_SIMPLE
    case 9: phase_gdn_prep_simple(p); break;
    case 10: phase_gdn_scan_simple(p, lds); break;
#else
    case 9: phase_gdn_prep<false, 16>(p, lds); break;
    case 10: if ((blockIdx.x >> 3) >= 16) phase_p0_late(p, lds, (int)blockIdx.x - 128, (int)gridDim.x - 128); else phase_gdn_scan<false, 32>(p, lds); break;
#endif
    case 11: phase_gdn_post(p); break;
    case 12: { pg8::Gemm g{(const u16*)(ws + WS_OGN), (const u16*)(ws + WS_WOUT), S_, DM, GV}; pg8::StaticOrder S; S.init(S_, DM, G, c);
              EpiRes E{p.out, p.out, XB, ssq + 64 * S_}; pg8::gemm_phase<EpiRes, pg8::StaticOrder>(lds, g, S, E, nullptr); } break;
    default: break;
    }
}
#ifdef MK_TEST_PHASES
template <int PH> __global__ void __launch_bounds__(512, 2) t_ph(Params p) {
    extern __shared__ __attribute__((aligned(16))) unsigned char lds_raw[];
    run_phase<PH>(p, (LAS unsigned char*)lds_raw, lds_raw);
}
template __global__ void t_ph<0>(Params); template __global__ void t_ph<1>(Params); template __global__ void t_ph<2>(Params); template __global__ void t_ph<3>(Params);
template __global__ void t_ph<4>(Params); template __global__ void t_ph<5>(Params); template __global__ void t_ph<6>(Params); template __global__ void t_ph<7>(Params);
template __global__ void t_ph<8>(Params); template __global__ void t_ph<9>(Params); template __global__ void t_ph<10>(Params); template __global__ void t_ph<11>(Params);
template __global__ void t_ph<12>(Params);
#endif
__global__ void __launch_bounds__(512, 2) mk_fwd(Params p) {
    extern __shared__ __attribute__((aligned(16))) unsigned char lds_raw[];
    LAS unsigned char* lds = (LAS unsigned char*)lds_raw;
    cg::grid_group grid = cg::this_grid();
    const int lo = p.ph_lo, hi = p.ph_hi;
    if (otid() < 4) ((LAS unsigned*)(lds + LDS_BARST))[otid()] = 0u;
    __syncthreads();
    const XcdBarrier bar = xcd_barrier_post((unsigned*)(p.ws + WS_BAR), (volatile LAS unsigned*)(lds + LDS_BARST));
#define GSYNC() xcd_barrier(bar)
    if (hi > 1000) grid.sync();
#define PHASE(k) if (lo <= (k) && (k) < hi) { if ((MK_DUP_MASK >> (k)) & 1) { run_phase<k>(p, lds, lds_raw); __syncthreads(); } run_phase<k>(p, lds, lds_raw); if ((k) + 1 < hi) GSYNC(); }
    PHASE(0) PHASE(1)
    if (lo <= 2 && 2 < hi) { phase_qknorm(p); GSYNC(); }
    PHASE(2) PHASE(3) PHASE(4) PHASE(5) PHASE(6) PHASE(7) PHASE(8) PHASE(9) PHASE(10)
#if MK_HYBRID
#if MK_CHECK
    { phase_gdn_prep<true, MK_HYBRID>(p, lds); grid.sync(); phase_gdn_check<MK_HYBRID>(p, lds); grid.sync();
      const float code = 1000.f * (float)(*(const unsigned*)(p.ws + WS_MISC));
      for (size_t i = (size_t)blockIdx.x * 512 + otid(); i < (size_t)S_ * DM; i += (size_t)gridDim.x * 512) p.out[i] = code;
      return; }
#endif
    if (lo <= 10 && 11 < hi) { phase_gdn_prep<true, MK_HYBRID>(p, lds); grid.sync(); phase_gdn_scan<true, 2 * MK_HYBRID>(p, lds); grid.sync(); }
#endif
    PHASE(11) PHASE(12) PHASE(13) PHASE(14) PHASE(15)
#undef PHASE
#ifdef MK_DUMP_OFF
    grid.sync();
    { const u16* src = (const u16*)(p.ws + (size_t)MK_DUMP_OFF); const size_t gt = (size_t)blockIdx.x * 512 + otid(), NT = (size_t)gridDim.x * 512;
      for (size_t i = gt; i < (size_t)S_ * DM; i += NT) {
          const int cat = (int)(i / 3355443), j = (int)(i % 3355443); if (cat > 4) { p.out[i] = 0.f; continue; }
          const int blk = j & 4095, e = (j >> 12) & 4095;
          const int opx = cat == 0 ? OP_QD : cat == 1 ? OP_KD : cat == 2 ? OP_QK : cat == 3 ? OP_W : OP_U;
          const float wgt = cat == 0 ? 1e6f : cat == 1 ? 1e5f : cat == 2 ? 1e4f : cat == 3 ? 1e3f : 1e2f;
          const float v = bf2f(src[(size_t)blk * (OPS_BLK / 2) + opx / 2 + e * 4]);
          p.out[i] = !(__builtin_fabsf(v) < 50.f) ? wgt : 0.f; } }
#endif
}

#ifndef MK_PH_HI
#endif
extern "C" void kernel_launch(void* const* d_in, const int* in_sizes, int n_in, void* d_out, int out_size, void* d_ws, size_t ws_size, hipStream_t stream) {
    static int grid = 0;
    if (grid == 0) {
        if (n_in != 22 || out_size != S_ * DM || ws_size < WS_END) { fprintf(stderr, "kernel_launch: unexpected shapes (n_in %d out %d ws %zu)\n", n_in, out_size, ws_size); grid = -1; return; }
        int dev = 0, cus = 0, per_cu = 0;
        (void)hipGetDevice(&dev); (void)hipDeviceGetAttribute(&cus, hipDeviceAttributeMultiprocessorCount, dev);
        if (hipFuncSetAttribute((const void*)mk_fwd, hipFuncAttributeMaxDynamicSharedMemorySize, LDS_BYTES) != hipSuccess) { fprintf(stderr, "kernel_launch: hipFuncSetAttribute failed\n"); grid = -1; return; }
        if (hipOccupancyMaxActiveBlocksPerMultiprocessor(&per_cu, (const void*)mk_fwd, 512, LDS_BYTES) != hipSuccess || per_cu < 1) { fprintf(stderr, "kernel_launch: occupancy query says %d\n", per_cu); per_cu = 1; }
        (void)hipGetLastError();
        if (cus <= 0) cus = 256;
        grid = cus;
    }
    if (grid < 0) return;
    if (hipMemsetAsync((char*)d_ws + WS_BAR, 0, XCD_BAR_WORDS * 4, stream) != hipSuccess) { fprintf(stderr, "kernel_launch: memset of the barrier words failed\n"); return; }
    Params p{};
    for (int i = 0; i < 22; ++i) p.in[i] = (const float*)d_in[i];
    p.out = (float*)d_out; p.ws = (unsigned char*)d_ws;
#if MK_PER_PHASE
    for (int ph = 0; ph < NPHASE; ++ph) { p.ph_lo = ph; p.ph_hi = ph + 1; void* args[] = {&p};
        hipError_t e = hipLaunchCooperativeKernel((const void*)mk_fwd, dim3(grid), dim3(512), args, LDS_BYTES, stream);
        if (e != hipSuccess) { fprintf(stderr, "launch %d failed: %s\n", ph, hipGetErrorString(e)); break; } }
#else
    p.ph_lo = 0; p.ph_hi = MK_PH_HI; void* args[] = {&p};
    hipError_t e = hipLaunchCooperativeKernel((const void*)mk_fwd, dim3(grid), dim3(512), args, LDS_BYTES, stream);
    if (e != hipSuccess) fprintf(stderr, "cooperative launch failed: %s (grid %d)\n", hipGetErrorString(e), grid);
#endif
}
```

```cpp
#include <hip/hip_runtime.h>
#include <hip/hip_bf16.h>
#include <hip/hip_cooperative_groups.h>
#include <cstdio>
#include <cstdint>
namespace cg = cooperative_groups;
__device__ __forceinline__ int otid() { int t = (int)__builtin_amdgcn_workitem_id_x(); asm volatile("" : "+v"(t)); return t; }
#include <hip/hip_runtime.h>
namespace pg8 {
#define PG8_LAS __attribute__((address_space(3)))
typedef unsigned short bf16_t;
typedef short bf16x8 __attribute__((ext_vector_type(8)));
typedef float f32x4 __attribute__((ext_vector_type(4)));
typedef unsigned u32x4 __attribute__((ext_vector_type(4)));
constexpr int BM = 256, BK = 64, HALF = 128, HTB = HALF * BK * 2  , STAGE_BYTES = 8 * HTB, NXCD = 8, WGM = 8;

__host__ __device__ __forceinline__ int lds_byte(int r, int c) { const int st = (r >> 4) * 2 + (c >> 5), rr = r & 15, cc = c & 31, ob = rr * 64 + cc * 2; return st * 1024 + (ob ^ (((ob >> 9) & 1) << 5)); }
__host__ __device__ __forceinline__ void stage_rc(int b, int& R, int& C) { const int st = b / 1024, sb = b % 1024, swz = sb ^ (((sb >> 9) & 1) << 5); R = (st >> 1) * 16 + swz / 64; C = (st & 1) * 32 + (swz % 64) / 2; }
__host__ __device__ __forceinline__ int perm32(int rho) { const int n = rho >> 4, i = rho & 15; return 8 * (i >> 2) + 4 * n + (i & 3); }

struct Unit { int pm, pn; };
struct Gemm { const bf16_t* A; const bf16_t* Bt; int M, N, K; };

struct StaticOrder {
    int nM, nN, nwg, G, c;
    __host__ __device__ void init(int M, int N, int G_, int c_) { nM = M / BM; nN = N / BM; nwg = nM * nN; G = G_; c = c_; }
    __host__ __device__ bool next(int i, Unit& u) const {
        const long L = (long)i * G + c; if (L >= nwg) return false;
        int wgid = (int)L; { const int q = nwg / NXCD, r = nwg % NXCD, xcd = wgid % NXCD, off = wgid / NXCD; wgid = (xcd < r ? xcd * (q + 1) : r * (q + 1) + (xcd - r) * q) + off; }
        const int nig = WGM * nN, gid = wgid / nig, fm = gid * WGM, gsz = (nM - fm) < WGM ? (nM - fm) : WGM;
        u.pm = fm + ((wgid % nig) % gsz); u.pn = (wgid % nig) / gsz; return true;
    }
    __device__ __forceinline__ void a_ready(const Unit&) const {}
    __device__ __forceinline__ void done(const Unit&) const {}
};
struct CountedOrder : StaticOrder {
    const unsigned* ready; unsigned need; unsigned* tmo;
    __device__ __forceinline__ void a_ready(const Unit& u) const {
        if (otid() < 64) {
            const unsigned long long t0 = __builtin_amdgcn_s_memrealtime(); unsigned polls = 0;
            while ((unsigned)__builtin_amdgcn_readfirstlane(__hip_atomic_load(ready + 64 * u.pm, __ATOMIC_RELAXED, __HIP_MEMORY_SCOPE_AGENT)) < need) {
                if ((++polls & 255u) == 0u && __builtin_amdgcn_readfirstlane(__hip_atomic_load(tmo, __ATOMIC_RELAXED, __HIP_MEMORY_SCOPE_AGENT)) != 0u) break;
                if (__builtin_amdgcn_s_memrealtime() - t0 > 2000000ull) {
                    if (otid() == 0) { unsigned expect = 0u; __hip_atomic_compare_exchange_strong(tmo + 1, &expect, 0x600u | (unsigned)(u.pm & 0xff), __ATOMIC_RELAXED, __ATOMIC_RELAXED, __HIP_MEMORY_SCOPE_AGENT); __hip_atomic_store(tmo, 1u, __ATOMIC_RELAXED, __HIP_MEMORY_SCOPE_AGENT); }
                    break; }
                __builtin_amdgcn_s_sleep(2); }
            __builtin_amdgcn_fence(__ATOMIC_ACQUIRE, "agent");
            asm volatile("s_waitcnt vmcnt(0)" ::: "memory");
        }
#if !defined(BROKEN_HOOK_NO_BARRIER)
        asm volatile("" ::: "memory"); __builtin_amdgcn_s_barrier(); asm volatile("" ::: "memory");
#endif
    }
};

template <class Epi, class Sched, bool STAMP = false>
__device__ __forceinline__ void gemm_phase(PG8_LAS unsigned char* lds, const Gemm g, const Sched& S, const Epi& E, unsigned long long* stamps) {
    const int tid = otid(), wid = __builtin_amdgcn_readfirstlane(tid >> 6), lane = tid & 63, wr = wid >> 2, wc = wid & 3, fr = lane & 15, fq = lane >> 4;
    const int K = g.K, nt = K / BK;
    int ts_lo = 0, ts_hi = 0, nts = 0; const unsigned long long rt_entry = STAMP ? (unsigned long long)wall_clock64() : 0ull;
#define PG8_STAMP() do { if (STAMP && wid == 0 && nts < 64) { const unsigned long long _c = (unsigned long long)clock64(); \
        ts_lo = (lane == nts) ? (int)(unsigned)_c : ts_lo; ts_hi = (lane == nts) ? (int)(unsigned)(_c >> 32) : ts_hi; ++nts; } } while (0)
    PG8_STAMP();
    unsigned voffA[2], voffB[2];
#pragma unroll
    for (int i = 0; i < 2; ++i) { int R, C; stage_rc(tid * 16 + i * 8192, R, C); const int Rb = Epi::PERM ? ((R & ~31) + perm32(R & 31)) : R;
        voffA[i] = (unsigned)(R * K + C) * 2u; voffB[i] = (unsigned)(Rb * K + C) * 2u; }
    const size_t kstep = (size_t)(BK * 2);
    const size_t hstep = (size_t)HALF * K * 2;
    const size_t tstep = 2 * hstep;
    const unsigned ldsw = (unsigned)wid * 1024u;
    const int aoff = lds_byte(wr * 64 + fr, fq * 8), boff = lds_byte(wc * 32 + fr, fq * 8);
#define PG8_SA(b, h) (((b) * 2 + (h)) * HTB)
#define PG8_SB(b, h) ((4 + (b) * 2 + (h)) * HTB)
#define PG8_STAGE(bufoff, gbase, voff) do { _Pragma("unroll") for (int _i = 0; _i < 2; ++_i) \
        __builtin_amdgcn_global_load_lds((const unsigned*)((const char*)(gbase) + (voff)[_i]), (PG8_LAS unsigned*)(lds + (bufoff) + ldsw + _i * 8192), 16, 0, 0); } while (0)
#define PG8_LDA(dst, b, h) do { _Pragma("unroll") for (int m = 0; m < 4; ++m) _Pragma("unroll") for (int k = 0; k < 2; ++k) dst[m][k] = *(const PG8_LAS bf16x8*)(lds + PG8_SA(b, h) + aoff + m * 2048 + k * 1024); } while (0)
#define PG8_LDB(dst, b, h) do { _Pragma("unroll") for (int n = 0; n < 2; ++n) _Pragma("unroll") for (int k = 0; k < 2; ++k) dst[n][k] = *(const PG8_LAS bf16x8*)(lds + PG8_SB(b, h) + boff + n * 2048 + k * 1024); } while (0)
#define PG8_MMA(ai, bj, At, Bt) do { __builtin_amdgcn_s_setprio(1); _Pragma("unroll") for (int m = 0; m < 4; ++m) _Pragma("unroll") for (int n = 0; n < 2; ++n) _Pragma("unroll") for (int k = 0; k < 2; ++k) \
        acc[ai][bj][m][n] = __builtin_amdgcn_mfma_f32_16x16x32_bf16(Bt[n][k], At[m][k], acc[ai][bj][m][n], 0, 0, 0); __builtin_amdgcn_s_setprio(0); } while (0)
#define PG8_WAIT_V(n) asm volatile("s_waitcnt vmcnt(" #n ")" ::: "memory")
#define PG8_WAIT_L(n) asm volatile("s_waitcnt lgkmcnt(" #n ")" ::: "memory")
#define PG8_BAR __builtin_amdgcn_s_barrier()
#define PG8_SCHED __builtin_amdgcn_sched_barrier(0)
    Unit cur, nxt; int ui = 0;
    if (!S.next(0, cur)) return;
    f32x4 acc[2][2][4][2];
#pragma unroll
    for (int a = 0; a < 2; ++a)
#pragma unroll
        for (int b = 0; b < 2; ++b)
#pragma unroll
            for (int m = 0; m < 4; ++m)
#pragma unroll
                for (int n = 0; n < 2; ++n) acc[a][b][m][n] = (f32x4){0.f, 0.f, 0.f, 0.f};
    bf16x8 At[4][2], B0[2][2], B1[2][2];
    const char* cA = (const char*)g.A + (size_t)cur.pm * tstep; const char* cB = (const char*)g.Bt + (size_t)cur.pn * tstep;
    S.a_ready(cur);
    PG8_STAGE(PG8_SB(0, 0), cB, voffB); PG8_STAGE(PG8_SA(0, 0), cA, voffA); PG8_STAGE(PG8_SB(0, 1), cB + hstep, voffB); PG8_STAGE(PG8_SA(0, 1), cA + hstep, voffA);
    if (wr == 1) PG8_BAR;
    PG8_WAIT_V(4); PG8_BAR;
    PG8_STAGE(PG8_SB(1, 0), cB + kstep, voffB); PG8_STAGE(PG8_SA(1, 0), cA + kstep, voffA); PG8_STAGE(PG8_SB(1, 1), cB + hstep + kstep, voffB);
    PG8_WAIT_V(6); PG8_BAR;
    PG8_STAMP();
    for (;;) {
        const bool has_next = S.next(ui + 1, nxt);
        const char* nA = has_next ? (const char*)g.A + (size_t)nxt.pm * tstep : cA; const char* nB = has_next ? (const char*)g.Bt + (size_t)nxt.pn * tstep : cB;
        for (int t = 0; t < nt; t += 2) {
            const bool last = (t == nt - 2);
            const char* a1 = cA + (size_t)(t + 1) * kstep;
            const char* a2 = last ? nA : cA + (size_t)(t + 2) * kstep; const char* b2 = last ? nB : cB + (size_t)(t + 2) * kstep;
            const char* a3 = a2 + kstep; const char* b3 = b2 + kstep;
            if (last && has_next) S.a_ready(nxt);
            PG8_LDB(B0, 0, 0); PG8_SCHED; PG8_LDA(At, 0, 0); PG8_STAGE(PG8_SA(1, 1), a1 + hstep, voffA);
            PG8_WAIT_L(8); PG8_BAR; PG8_WAIT_L(0); PG8_MMA(0, 0, At, B0); PG8_BAR; PG8_SCHED;
            PG8_LDB(B1, 0, 1); PG8_STAGE(PG8_SB(0, 0), b2, voffB);
            PG8_BAR; PG8_WAIT_L(0); PG8_MMA(0, 1, At, B1); PG8_BAR;
            PG8_LDA(At, 0, 1); PG8_STAGE(PG8_SA(0, 0), a2, voffA);
            PG8_BAR; PG8_WAIT_L(0); PG8_MMA(1, 0, At, B0); PG8_BAR; PG8_SCHED;
            PG8_STAGE(PG8_SB(0, 1), b2 + hstep, voffB);
            PG8_WAIT_V(6); PG8_BAR; PG8_MMA(1, 1, At, B1); PG8_BAR;
            PG8_LDB(B0, 1, 0); PG8_SCHED; PG8_LDA(At, 1, 0); PG8_STAGE(PG8_SA(0, 1), a2 + hstep, voffA);
            PG8_WAIT_L(8); PG8_BAR; PG8_WAIT_L(0); PG8_MMA(0, 0, At, B0); PG8_BAR; PG8_SCHED;
            PG8_LDB(B1, 1, 1); PG8_STAGE(PG8_SB(1, 0), b3, voffB);
            PG8_BAR; PG8_WAIT_L(0); PG8_MMA(0, 1, At, B1); PG8_BAR;
            PG8_LDA(At, 1, 1); PG8_STAGE(PG8_SA(1, 0), a3, voffA);
            PG8_BAR; PG8_WAIT_L(0); PG8_MMA(1, 0, At, B0); PG8_BAR; PG8_SCHED;
            PG8_STAGE(PG8_SB(1, 1), b3 + hstep, voffB);
            PG8_WAIT_V(6); PG8_BAR; PG8_MMA(1, 1, At, B1); PG8_BAR;
        }
        PG8_STAMP();
        if constexpr (!Epi::AFTER_DRAIN) { E(acc, cur, wr, wc, fr, fq); S.done(cur); }
        PG8_STAMP();
        if (!has_next) break;
#pragma unroll
        for (int a = 0; a < 2; ++a)
#pragma unroll
            for (int b = 0; b < 2; ++b)
#pragma unroll
                for (int m = 0; m < 4; ++m)
#pragma unroll
                    for (int n = 0; n < 2; ++n) acc[a][b][m][n] = (f32x4){0.f, 0.f, 0.f, 0.f};
        cur = nxt; cA = nA; cB = nB; ++ui;
    }
    PG8_WAIT_V(0);
    if (wr == 0) PG8_BAR;
    PG8_BAR;
    if constexpr (Epi::AFTER_DRAIN) { E.fused(acc, cur, wr, wc, fr, fq, lds, wid, lane); S.done(cur); }
    PG8_STAMP();
    if (STAMP && wid == 0) { stamps[lane] = lane < nts ? (((unsigned long long)(unsigned)ts_hi << 32) | (unsigned)ts_lo) : 0ull;
        if (lane == 62) stamps[62] = rt_entry; if (lane == 63) stamps[63] = (unsigned long long)wall_clock64(); }
#undef PG8_STAMP
#undef PG8_SA
#undef PG8_SB
#undef PG8_STAGE
#undef PG8_LDA
#undef PG8_LDB
#undef PG8_MMA
#undef PG8_WAIT_V
#undef PG8_WAIT_L
#undef PG8_BAR
#undef PG8_SCHED
}
}
namespace att {
constexpr int D = 128;
constexpr float SCALE = 0.08838834764831845f;
constexpr int NW = 8, QBLK = 32, KVBLK = 64, QB = NW * QBLK;
constexpr int SHM_V = KVBLK * D * 2, SHM_K = KVBLK * D * 2;
constexpr int LDS_BYTES = 2 * SHM_V + 2 * SHM_K + NW * 64 * 4;
constexpr float THR = 8.f; constexpr bool WSKIP = false;

using bf16 = __hip_bfloat16;
typedef short bf16x8 __attribute__((ext_vector_type(8)));
typedef short s16x4 __attribute__((ext_vector_type(4)));
typedef float f32x16 __attribute__((ext_vector_type(16)));
typedef float f32x4 __attribute__((ext_vector_type(4)));
typedef unsigned u32x4 __attribute__((ext_vector_type(4)));
template <class A, class Bt> struct same_t { static constexpr bool v = false; };
template <class A> struct same_t<A, A> { static constexpr bool v = true; };

#define KSWZ(row, colB) ((row) * 256 + ((colB) ^ (((row) & 7) << 4)))
#define SBAR() __builtin_amdgcn_sched_barrier(0)
__device__ __forceinline__ int v_st(int k, int c) { const int kk = (k & ~0xC) | ((k & 4) << 1) | ((k & 8) >> 1); return ((kk >> 3) * 4 + (c >> 5)) * 512 + ((kk & 7) * 32 + (c & 31)) * 2; }
__device__ __forceinline__ int v_rd_base(int lane) { return ((lane & 3) << 3) | (((lane >> 2) & 3) << 6) | (((lane >> 4) & 1) << 5) | (((lane >> 5) & 1) << 8); }
constexpr int v_rd_off(int d0, int ks, int half) { return d0 * 512 + ks * 4096 + half * 2048; }
__device__ __forceinline__ int crow(int r, int hi) { return (r & 3) + 8 * (r >> 2) + 4 * hi; }
__device__ __forceinline__ unsigned cvtpk(float lo, float hi) {
    unsigned r; asm volatile("v_cvt_pk_bf16_f32 %0, %1, %2" : "=v"(r) : "v"(lo), "v"(hi)); return r;
}
__device__ __forceinline__ bf16x8 pack8(f32x4 a, f32x4 b) {
    u32x4 w = {cvtpk(a[0], a[1]), cvtpk(a[2], a[3]), cvtpk(b[0], b[1]), cvtpk(b[2], b[3])};
    return *reinterpret_cast<bf16x8*>(&w);
}
template <class T> __device__ __forceinline__ bf16x8 load8(const T* p) {
    if constexpr (same_t<T, float>::v) { return pack8(*(const f32x4*)p, *(const f32x4*)(p + 4)); }
    else { return *reinterpret_cast<const bf16x8*>(p); }
}
__device__ __forceinline__ void mask_tile(f32x16& p0, f32x16& p1, int dq, unsigned W) {
    const float NEG = -__builtin_inff();
#pragma unroll
    for (int r = 0; r < 16; ++r) {
        const int c = (r & 3) + 8 * (r >> 2);
        if ((unsigned)(dq - c) >= W) p0[r] = NEG;
        if ((unsigned)(dq - c - 32) >= W) p1[r] = NEG;
    }
}
__device__ __forceinline__ void partialSM(f32x16& p0, f32x16& p1, float& m_reg, float& mn, float& alpha) {
    float pmax = p0[0]; for (int r = 1; r < 16; ++r) pmax = fmaxf(pmax, p0[r]); for (int r = 0; r < 16; ++r) pmax = fmaxf(pmax, p1[r]);
    { auto rr = __builtin_amdgcn_permlane32_swap(__float_as_uint(pmax), __float_as_uint(pmax), false, false);
      pmax = fmaxf(__uint_as_float(rr[0]), __uint_as_float(rr[1])); }
    constexpr float THR2 = THR * 1.4426950408889634f;
    if (__builtin_expect(__all(pmax <= THR2), 1)) { alpha = 1.f; }
    else { const float d = fmaxf(pmax, 0.f); alpha = __builtin_amdgcn_exp2f(-d); m_reg += d;
           for (int r = 0; r < 16; ++r) p0[r] -= d; for (int r = 0; r < 16; ++r) p1[r] -= d; }
    mn = m_reg;
    for (int r = 0; r < 16; ++r) p0[r] = __builtin_amdgcn_exp2f(p0[r]);
}
__device__ __forceinline__ void finishSM(f32x16& p0, f32x16& p1, float alpha, float& l_reg, bf16x8& pa0, bf16x8& pa1, bf16x8& pa2, bf16x8& pa3) {
    for (int r = 0; r < 16; ++r) p1[r] = __builtin_amdgcn_exp2f(p1[r]);
    float ps = 0; for (int r = 0; r < 16; ++r) ps += p0[r]; for (int r = 0; r < 16; ++r) ps += p1[r];
    { auto rr = __builtin_amdgcn_permlane32_swap(__float_as_uint(ps), __float_as_uint(ps), false, false);
      ps = __uint_as_float(rr[0]) + __uint_as_float(rr[1]); }
    l_reg = l_reg * alpha + ps;
#define PK4(P, B_, OUT) do { unsigned a0 = cvtpk(P[B_+0], P[B_+1]), a1 = cvtpk(P[B_+2], P[B_+3]);                          \
        unsigned b0 = cvtpk(P[B_+4], P[B_+5]), b1 = cvtpk(P[B_+6], P[B_+7]);                                             \
        auto r0 = __builtin_amdgcn_permlane32_swap(a0, b0, false, false); auto r1 = __builtin_amdgcn_permlane32_swap(a1, b1, false, false); \
        u32x4 w = {r0[0], r1[0], r0[1], r1[1]}; OUT = *reinterpret_cast<bf16x8*>(&w); } while (0)
    PK4(p0, 0, pa0); PK4(p0, 8, pa1); PK4(p1, 0, pa2); PK4(p1, 8, pa3);
#undef PK4
}
template <int KB, bool SK>
__device__ __forceinline__ void qkt(f32x16& p0, f32x16& p1, const char* K_lds, int r32, int hi, const bf16x8* qr, bool act, float nsl, float dqf, bool lin, float mreg) {
    if (SK && !act) { const float NEG = -__builtin_inff();
#pragma unroll
        for (int r = 0; r < 16; ++r) { p0[r] = NEG; p1[r] = NEG; } return; }
    {
        const float nn = -nsl;
        if (lin) {
            const float base = __builtin_fmaf(nsl, dqf, -mreg);
#pragma unroll
            for (int r = 0; r < 16; ++r) { const float c = (float)((r & 3) + 8 * (r >> 2)); p0[r] = __builtin_fmaf(nn, c, base); p1[r] = __builtin_fmaf(nn, c + 32.f, base); }
        } else {
            const float base = nsl * dqf;
#pragma unroll
            for (int r = 0; r < 16; ++r) { const float c = (float)((r & 3) + 8 * (r >> 2));
                p0[r] = __uint_as_float(__float_as_uint(__builtin_fmaf(nn, c, base)) | 0x80000000u) - mreg; p1[r] = __uint_as_float(__float_as_uint(__builtin_fmaf(nn, c + 32.f, base)) | 0x80000000u) - mreg; }
        }
    }
    const char* kb[4];
#pragma unroll
    for (int dd = 0; dd < 4; ++dd) kb[dd] = K_lds + KB * SHM_K + KSWZ(r32, (dd * 16 + hi * 8) * 2);
#pragma unroll
    for (int d0 = 0; d0 < 8; ++d0) { const char* a = kb[d0 & 3] + (d0 >> 2) * 128;
        bf16x8 b0 = *reinterpret_cast<const bf16x8*>(a);
        bf16x8 b1 = *reinterpret_cast<const bf16x8*>(a + 32 * 256);
        p0 = __builtin_amdgcn_mfma_f32_32x32x16_bf16(b0, qr[d0], p0, 0, 0, 0);
        p1 = __builtin_amdgcn_mfma_f32_32x32x16_bf16(b1, qr[d0], p1, 0, 0, 0); }
}
template <int VB, bool SK>
__device__ __forceinline__ void pv_tile(f32x16* o, int vb0, bf16x8 pa0, bf16x8 pa1, bf16x8 pa2, bf16x8 pa3, bool act) {
    if (SK && !act) return;
#define TRRD(dst, off) asm volatile("ds_read_b64_tr_b16 %0, %1 offset:%2" : "=&v"(dst) : "v"(vb0), "i"(off) : "memory")
#define PV_D0(d0) do { s16x4 l0, l1, l2, l3, h0, h1, h2, h3; constexpr int b_ = VB * SHM_V + v_rd_off(d0, 0, 0);     \
        TRRD(l0, b_); TRRD(h0, b_ + 2048); TRRD(l1, b_ + 4096); TRRD(h1, b_ + 6144); TRRD(l2, b_ + 8192); TRRD(h2, b_ + 10240); TRRD(l3, b_ + 12288); TRRD(h3, b_ + 14336); \
        asm volatile("s_waitcnt lgkmcnt(0)" ::: "memory"); SBAR();                 \
        o[d0] = __builtin_amdgcn_mfma_f32_32x32x16_bf16(pa0, (bf16x8){l0[0], l0[1], l0[2], l0[3], h0[0], h0[1], h0[2], h0[3]}, o[d0], 0, 0, 0);   \
        o[d0] = __builtin_amdgcn_mfma_f32_32x32x16_bf16(pa1, (bf16x8){l1[0], l1[1], l1[2], l1[3], h1[0], h1[1], h1[2], h1[3]}, o[d0], 0, 0, 0);   \
        o[d0] = __builtin_amdgcn_mfma_f32_32x32x16_bf16(pa2, (bf16x8){l2[0], l2[1], l2[2], l2[3], h2[0], h2[1], h2[2], h2[3]}, o[d0], 0, 0, 0);   \
        o[d0] = __builtin_amdgcn_mfma_f32_32x32x16_bf16(pa3, (bf16x8){l3[0], l3[1], l3[2], l3[3], h3[0], h3[1], h3[2], h3[3]}, o[d0], 0, 0, 0); } while (0)
    PV_D0(0); PV_D0(1); PV_D0(2); PV_D0(3);
#undef PV_D0
#undef TRRD
}

template <class TIn, class TOut> struct BlockRef { const TIn* Q; const TIn* K; const TIn* V; TOut* O; int P0; int W; float nsl; };
template <class TIn> struct Seam {
    bf16x8 qr[8];
    bf16x8 st_v0, st_v1, st_k0, st_k1; f32x4 sf0, sf1, sf2, sf3;
    f32x4 tq[16];
};
__device__ __forceinline__ int swa_jlo(int P0, int W) { const int lowk = P0 - W + 1; return lowk > 0 ? lowk / KVBLK : 0; }
#define ROW(p, k0, rr) ((p) + (size_t)((k0) + (rr)) * D + sc)
#define VMW() asm volatile("s_waitcnt vmcnt(0)" ::: "memory")
#define VMWN(n) asm volatile("s_waitcnt vmcnt(%0)" :: "i"(n) : "memory")
#define SLOAD_H(Kp, Vp, k0) do { S.st_v0 = load8<TIn>(ROW(Vp, k0, sr)); S.st_v1 = load8<TIn>(ROW(Vp, k0, 32 + sr));              \
                         S.st_k0 = load8<TIn>(ROW(Kp, k0, sr)); S.st_k1 = load8<TIn>(ROW(Kp, k0, 32 + sr)); } while (0)
#define SWRITE_HK(bf) do { *(bf16x8*)(K_lds + (bf) * SHM_K + kws) = S.st_k0; *(bf16x8*)(K_lds + (bf) * SHM_K + kws + 32 * 256) = S.st_k1; } while (0)
#define SWRITE_HV(bf) do { *(bf16x8*)(V_lds + (bf) * SHM_V + vst0) = S.st_v0; *(bf16x8*)(V_lds + (bf) * SHM_V + vst1) = S.st_v1; } while (0)
#define SWRITE_H(bf) do { SWRITE_HV(bf); SWRITE_HK(bf); } while (0)
#define SLOAD_F(p, k0) do { S.sf0 = *(const f32x4*)ROW(p, k0, sr); S.sf1 = *(const f32x4*)(ROW(p, k0, sr) + 4);                \
                            S.sf2 = *(const f32x4*)ROW(p, k0, 32 + sr); S.sf3 = *(const f32x4*)(ROW(p, k0, 32 + sr) + 4); } while (0)
#define SWRITE_KF(bf) do { *(bf16x8*)(K_lds + (bf) * SHM_K + kws) = pack8(S.sf0, S.sf1); *(bf16x8*)(K_lds + (bf) * SHM_K + kws + 32 * 256) = pack8(S.sf2, S.sf3); } while (0)
#define SWRITE_VF(bf) do { *(bf16x8*)(V_lds + (bf) * SHM_V + vst0) = pack8(S.sf0, S.sf1); *(bf16x8*)(V_lds + (bf) * SHM_V + vst1) = pack8(S.sf2, S.sf3); } while (0)
template <class TIn, class TOut>
__device__ __forceinline__ void causal_swa_prime(const BlockRef<TIn, TOut>& cur, char* lds, Seam<TIn>& S) {
    constexpr bool F32 = same_t<TIn, float>::v;
    const int tid = otid(), wid = __builtin_amdgcn_readfirstlane(tid >> 6), lane = tid & 63, r32 = lane & 31, hi = lane >> 5;
    const int sr = tid >> 4, sc = (tid & 15) * 8, kws = KSWZ(sr, sc * 2); char* K_lds = lds + 2 * SHM_V;
    const int kb0 = swa_jlo(cur.P0, cur.W) * KVBLK;
    for (int d0 = 0; d0 < 8; ++d0) S.qr[d0] = load8<TIn>(cur.Q + (size_t)(wid * QBLK + r32) * D + d0 * 16 + hi * 8);
    if constexpr (F32) { SLOAD_F((const float*)cur.K, kb0); VMW(); SWRITE_KF(0); SBAR(); SLOAD_F((const float*)cur.V, kb0); }
    else { SLOAD_H(cur.K, cur.V, kb0); VMW(); SWRITE_HK(0); }
    __syncthreads();
}
template <class TIn, class TOut>
__device__ __forceinline__ void causal_swa_block(const BlockRef<TIn, TOut>& cur, const BlockRef<TIn, TOut>& nxt, int skv, char* lds, Seam<TIn>& S) {
    constexpr bool F32 = same_t<TIn, float>::v;
    const int tid = otid(), wid = __builtin_amdgcn_readfirstlane(tid >> 6), lane = tid & 63, r32 = lane & 31, hi = lane >> 5;
    const int j_lo = swa_jlo(cur.P0, cur.W); const float nsl = cur.nsl;
    int j_hi = (cur.P0 + QB - 1) / KVBLK + 1; if (j_hi > skv / KVBLK) j_hi = skv / KVBLK;
    const int NT = j_hi - j_lo;
    const int kbn = swa_jlo(nxt.P0, nxt.W) * KVBLK;
    const int qlo = cur.P0 + wid * QBLK, qlom = qlo | 63, qm = ((qlo + r32) | 63) - 4 * hi, qt4 = qlo + r32 - 4 * hi;
    char* V_lds = lds; char* K_lds = lds + 2 * SHM_V;
    float* ws = (float*)(lds + 2 * SHM_V + 2 * SHM_K) + wid * 64; float* li_l = ws, * al_l = ws + 32;
    float m_reg = 0.f, l_reg = 0; f32x16 o[4] = {};
    const int sr = tid >> 4, sc = (tid & 15) * 8, vst0 = v_st(sr, sc), vst1 = v_st(32 + sr, sc), kws = KSWZ(sr, sc * 2);
    const int vb0 = (int)(uintptr_t)V_lds + v_rd_base(lane);
    const TIn* Kh = cur.K; const TIn* Vh = cur.V;
#define RESC(a) do { if (__any((a) < 1.f)) { if (hi == 0) al_l[r32] = (a); asm volatile("s_waitcnt lgkmcnt(0)" ::: "memory");              \
                     for (int d_ = 0; d_ < 4; ++d_) for (int r = 0; r < 16; ++r) o[d_][r] *= al_l[crow(r, hi)]; } } while (0)
#define KBASE(t) ((j_lo + (t)) * KVBLK)
#define ACT(t) (true)
#define MASKT(P0_, P1_, t) do { const int kb_ = KBASE(t); if (kb_ + KVBLK - 1 > qlom) mask_tile(P0_, P1_, qm - kb_, 0x40000000u); } while (0)
    constexpr int NQL = F32 ? 16 : 8;
    constexpr bool SK = WSKIP && !F32;
#define SEAM_K0() do { VMWN(NQL); if constexpr (F32) { SWRITE_KF(0); SBAR(); SLOAD_F((const float*)nxt.V, kbn); } else { SWRITE_HK(0); } SBAR(); } while (0)
    f32x16 pA0, pA1, pB0, pB1; float mnA, mnB, alA, alB; bf16x8 pa0, pa1, pa2, pa3;
    if constexpr (F32) { VMW(); SWRITE_VF(0); SBAR(); } else { SWRITE_HV(0); SBAR(); }
    if (NT > 1) { if constexpr (F32) SLOAD_F((const float*)Kh, KBASE(1)); else SLOAD_H(Kh, Vh, KBASE(1)); }
    SBAR(); qkt<0, SK>(pA0, pA1, K_lds, r32, hi, S.qr, ACT(0), nsl, (float)(qt4 - KBASE(0)), KBASE(0) + KVBLK - 1 <= qlo, m_reg);
    if constexpr (F32) { if (NT > 1) { VMW(); SWRITE_KF(1); SBAR(); SLOAD_F((const float*)Vh, KBASE(1)); } }
    MASKT(pA0, pA1, 0); partialSM(pA0, pA1, m_reg, mnA, alA);
    if (NT > 1) { VMW(); if constexpr (F32) { SWRITE_VF(1); SBAR(); if (NT > 2) SLOAD_F((const float*)Kh, KBASE(2)); } else SWRITE_H(1); }
    __syncthreads();
#define HALF_STEP(PX0, PX1, mnX, alX, PY0, PY1, alY, t, KB, VB, SB) do {                                                      \
        SBAR(); qkt<KB, SK>(PX0, PX1, K_lds, r32, hi, S.qr, ACT(t), nsl, (float)(qt4 - KBASE(t)), KBASE(t) + KVBLK - 1 <= qlo, m_reg);                                             \
        finishSM(PY0, PY1, alY, l_reg, pa0, pa1, pa2, pa3); SBAR();                                                           \
        if ((t) + 1 < NT) { if constexpr (F32) { VMW(); SWRITE_KF(SB); SBAR(); SLOAD_F((const float*)Vh, KBASE((t) + 1)); }  \
                            else { SLOAD_H(Kh, Vh, KBASE((t) + 1)); } SBAR(); }                                               \
        pv_tile<VB, SK>(o, vb0, pa0, pa1, pa2, pa3, ACT((t) - 1)); MASKT(PX0, PX1, (t)); partialSM(PX0, PX1, m_reg, mnX, alX);                                        \
        __syncthreads();                                                                                                      \
        if ((t) + 1 < NT) { VMW(); if constexpr (F32) { SWRITE_VF(SB); SBAR(); if ((t) + 2 < NT) SLOAD_F((const float*)Kh, KBASE((t) + 2)); } \
                            else { SWRITE_H(SB); } }                                                                          \
        RESC(alX); __syncthreads(); } while (0)
    for (int t = 1; t + 1 < NT; t += 2) {
        HALF_STEP(pB0, pB1, mnB, alB, pA0, pA1, alA, t, 1, 0, 0);
        HALF_STEP(pA0, pA1, mnA, alA, pB0, pB1, alB, t + 1, 0, 1, 1);
    }
    const bool even = (NT & 1) == 0;
    if (even) { SBAR(); qkt<1, SK>(pB0, pB1, K_lds, r32, hi, S.qr, ACT(NT - 1), nsl, (float)(qt4 - KBASE(NT - 1)), KBASE(NT - 1) + KVBLK - 1 <= qlo, m_reg); SBAR(); }
#define QROW(e) (nxt.Q + (size_t)(wid * QBLK + r32) * D + ((e) >> 1) * 16 + hi * 8 + ((e) & 1) * 4)
    if constexpr (F32) { SLOAD_F((const float*)nxt.K, kbn); SBAR();
#pragma unroll
        for (int e = 0; e < 8; ++e) S.tq[e] = *(const f32x4*)QROW(e); }
    else { SLOAD_H(nxt.K, nxt.V, kbn); SBAR();
#pragma unroll
        for (int d0 = 0; d0 < 8; ++d0) S.qr[d0] = load8<TIn>(nxt.Q + (size_t)(wid * QBLK + r32) * D + d0 * 16 + hi * 8); }
    SBAR();
    finishSM(pA0, pA1, alA, l_reg, pa0, pa1, pa2, pa3); SBAR();
    if constexpr (F32) {
#pragma unroll
        for (int e = 8; e < 16; ++e) S.tq[e] = *(const f32x4*)QROW(e); SBAR(); }
#undef QROW
    pv_tile<0, SK>(o, vb0, pa0, pa1, pa2, pa3, ACT(even ? NT - 2 : NT - 1));
    if (even) { MASKT(pB0, pB1, NT - 1); partialSM(pB0, pB1, m_reg, mnB, alB); __syncthreads(); RESC(alB);
        finishSM(pB0, pB1, alB, l_reg, pa0, pa1, pa2, pa3); SBAR(); pv_tile<1, SK>(o, vb0, pa0, pa1, pa2, pa3, ACT(NT - 1)); }
    SBAR(); SEAM_K0();
    if (hi == 0) li_l[r32] = l_reg; asm volatile("s_waitcnt lgkmcnt(0)" ::: "memory");
    float rli[16];
#pragma unroll
    for (int r = 0; r < 16; ++r) rli[r] = __builtin_amdgcn_rcpf(li_l[crow(r, hi)]);
    TOut* Ow = cur.O + (size_t)(wid * QBLK) * D;
#pragma unroll
    for (int r = 0; r < 16; ++r) { const int orow = crow(r, hi);
#pragma unroll
        for (int d0 = 0; d0 < 4; ++d0) { const float v = o[d0][r] * rli[r];
            if constexpr (same_t<TOut, float>::v) { Ow[(size_t)orow * D + d0 * 32 + r32] = v; }
            else { const float vn = __shfl_xor(v, 1);
                   if ((r32 & 1) == 0) *(unsigned*)(Ow + (size_t)orow * D + d0 * 32 + r32) = cvtpk(v, vn); } } }
    if constexpr (F32) {
#pragma unroll
        for (int d0 = 0; d0 < 8; ++d0) S.qr[d0] = pack8(S.tq[2 * d0], S.tq[2 * d0 + 1]); }
    __syncthreads();
#undef RESC
#undef KBASE
#undef ACT
#undef MASKT
#undef SEAM_K0
#undef HALF_STEP
}
#undef ROW
#undef VMW
#undef VMWN
#undef SLOAD_H
#undef SWRITE_HK
#undef SWRITE_HV
#undef SWRITE_H
#undef SLOAD_F
#undef SWRITE_KF
#undef SWRITE_VF

}
#ifndef MK_PER_PHASE
#define MK_PER_PHASE 0
#endif
#define MK_PH_HI 16
#define MK_GDN_SIMPLE 0
#define MK_ATT_WINDOW 1
#ifndef MK_DUP_MASK
#define MK_DUP_MASK 0
#endif
#ifndef MK_GDN_SIMPLE
#define MK_GDN_SIMPLE 1
#endif

#define LAS __attribute__((address_space(3)))
typedef unsigned short u16;
typedef short v8s __attribute__((ext_vector_type(8)));
typedef float v4f __attribute__((ext_vector_type(4)));
typedef float v16f __attribute__((ext_vector_type(16)));
typedef unsigned v4u __attribute__((ext_vector_type(4)));
typedef unsigned v2u __attribute__((ext_vector_type(2)));

constexpr int S_ = 8192, DM = 2048, NQKV = 6144, DFF = 5504, NUP = 11008, GIN = 12352, GINP = 12544, GV = 4096;
constexpr float EPS = 1e-6f;
constexpr size_t MiB = 1u << 20;
constexpr size_t WS_MISC = 0;
constexpr size_t WS_WUP1 = 1 * MiB, WS_WDN1 = 44 * MiB, WS_WIN = 66 * MiB, WS_WOUT = 115 * MiB;
constexpr size_t WS_XB = 131 * MiB;
constexpr size_t WS_WQKV = 163 * MiB, WS_WO = 187 * MiB, WS_WUP0 = 195 * MiB, WS_WDN0 = 238 * MiB;
constexpr size_t WS_QH = 260 * MiB, WS_KH = 292 * MiB, WS_VH = 324 * MiB, WS_OATT = 356 * MiB, WS_OB = 484 * MiB;
constexpr size_t WS_U = 260 * MiB, WS_Y = 432 * MiB;
constexpr size_t WS_PQKV = 163 * MiB, WS_Z = 291 * MiB, WS_BA = 355 * MiB, WS_OPS = 357 * MiB;
constexpr size_t WS_OG = WS_PQKV;
constexpr size_t WS_OGN = WS_OPS;
constexpr size_t WS_SSQ = 652 * MiB;
constexpr size_t WS_SQ = 357 * MiB, WS_SK = 421 * MiB, WS_SV = 485 * MiB, WS_SG = 613 * MiB;
#ifndef MK_HYBRID
#define MK_HYBRID 0
#endif
#ifndef MK_CHECK
#define MK_CHECK 0
#endif
constexpr size_t WS_OPS_H = 615 * MiB;
constexpr size_t WS_END = MK_HYBRID ? 688 * MiB : 656 * MiB;
static_assert(WS_KH - WS_QH == 32 * MiB && WS_VH - WS_KH == 32 * MiB, "EpiQKV tensor stride");
constexpr int OPS_BLK = 73984, OP_GL = 73728;
constexpr int OP_W = 0, OP_QD = 16384, OP_QK = 32768, OP_KD = 40960, OP_U = 57344;
constexpr int SCAN_BUF = 61440;
constexpr int LDS_BYTES = 139520;
constexpr int XCH_OFF = 131072;

typedef __bf16 bf16x2_t __attribute__((ext_vector_type(2)));
typedef float f32x2_t __attribute__((ext_vector_type(2)));
__device__ __forceinline__ unsigned cvtpk(float lo, float hi) { f32x2_t v = {lo, hi}; bf16x2_t r = __builtin_convertvector(v, bf16x2_t); return __builtin_bit_cast(unsigned, r); }
__device__ __forceinline__ u16 f2bf(float f) { return (u16)(cvtpk(f, 0.f) & 0xffffu); }
__device__ __forceinline__ float bf2f(u16 b) { return __uint_as_float(((unsigned)b) << 16); }
__device__ __forceinline__ float bflo(unsigned w) { return __uint_as_float(w << 16); }
__device__ __forceinline__ float bfhi(unsigned w) { return __uint_as_float(w & 0xffff0000u); }
__device__ __forceinline__ v8s pack8f(float a0, float a1, float a2, float a3, float a4, float a5, float a6, float a7) {
    v4u w = {cvtpk(a0, a1), cvtpk(a2, a3), cvtpk(a4, a5), cvtpk(a6, a7)}; return *reinterpret_cast<v8s*>(&w); }
__device__ __forceinline__ float wave_sum(float v) {
#pragma unroll
    for (int o = 1; o < 64; o <<= 1) v += __shfl_xor(v, o);
    return v; }
template <int CTRL> __device__ __forceinline__ float dpp_f(float v) { return __int_as_float(__builtin_amdgcn_update_dpp(0, __float_as_int(v), CTRL, 0xF, 0xF, false)); }
__device__ __forceinline__ float silu_f(float y) { return y * __builtin_amdgcn_rcpf(1.f + __expf(-y)); }
#define LDS_WAIT() asm volatile("s_waitcnt lgkmcnt(0)" ::: "memory")
#define VM_WAIT() asm volatile("s_waitcnt vmcnt(0)" ::: "memory")

struct Params { const float* in[22]; float* out; unsigned char* ws; int ph_lo, ph_hi; };
struct EpiQKV {
    static constexpr bool PERM = true, AFTER_DRAIN = false;
    u16* Qh; const float* qg; long gdelta; LAS float* xch;
    __device__ __forceinline__ void operator()(const pg8::f32x4 (&acc)[2][2][4][2], const pg8::Unit& u, int wr, int wc, int fr, int fq) const {
        asm volatile("" : "+v"(fr), "+v"(fq));
        const int tensor = u.pn >> 3, hh0 = 2 * (u.pn & 7);
        u16* T = Qh + (size_t)tensor * (16u << 20);
        const float* g = qg + (tensor & 1) * gdelta;
        const int cl = wc * 32 + fq * 8;
        if (tensor < 2) {
#pragma unroll
            for (int ai = 0; ai < 2; ++ai)
#pragma unroll
                for (int m = 0; m < 4; ++m)
#pragma unroll
                    for (int bj = 0; bj < 2; ++bj) {
                        const pg8::f32x4 a = acc[ai][bj][m][0], b = acc[ai][bj][m][1];
                        float s = (a[0] * a[0] + a[1] * a[1]) + (a[2] * a[2] + a[3] * a[3]) + (b[0] * b[0] + b[1] * b[1]) + (b[2] * b[2] + b[3] * b[3]);
                        s += __shfl_xor(s, 16); s += __shfl_xor(s, 32);
                        const int rowl = ai * 128 + wr * 64 + m * 16 + fr;
                        if (fq == 0) xch[(rowl * 2 + bj) * 4 + wc] = s;
                    }
            LDS_WAIT(); __builtin_amdgcn_s_barrier(); asm volatile("" ::: "memory");
        }
#pragma unroll
        for (int ai = 0; ai < 2; ++ai)
#pragma unroll
            for (int m = 0; m < 4; ++m) {
                const int rowl = ai * 128 + wr * 64 + m * 16 + fr; const size_t row = (size_t)u.pm * 256 + rowl;
#pragma unroll
                for (int bj = 0; bj < 2; ++bj) {
                    float rs = 1.f; v4f g0 = {1.f, 1.f, 1.f, 1.f}, g1 = g0;
                    if (tensor < 2) { g0 = *(const v4f*)(g + cl); g1 = *(const v4f*)(g + cl + 4); const v4f p = *(const LAS v4f*)(xch + (rowl * 2 + bj) * 4); rs = __builtin_amdgcn_rsqf(((p[0] + p[1]) + (p[2] + p[3])) * (1.f / 128.f) + EPS) * (tensor ? 1.f : 0.12751743082459868f); }
                    const pg8::f32x4 a = acc[ai][bj][m][0], b = acc[ai][bj][m][1];
                    v4u w; w.x = cvtpk(a[0] * rs * g0[0], a[1] * rs * g0[1]); w.y = cvtpk(a[2] * rs * g0[2], a[3] * rs * g0[3]);
                    w.z = cvtpk(b[0] * rs * g1[0], b[1] * rs * g1[1]); w.w = cvtpk(b[2] * rs * g1[2], b[3] * rs * g1[3]);
                    *(v4u*)(T + ((size_t)(hh0 + bj) * S_ + row) * 128 + cl) = w;
                }
            }
    }
};
__device__ __forceinline__ void phase_qknorm(const Params& p) {
    const int tid = otid(), lane = tid & 63, wave = tid >> 6;
    const int gw = blockIdx.x * 8 + wave, NGW = gridDim.x * 8;
    u16* QK = (u16*)(p.ws + WS_QH);
    const int e0 = 4 * (lane & 31);
    for (int it0 = gw * 4; it0 < 2 * 16 * S_ / 2; it0 += NGW * 4) {
        v2u w[4]; float ss[4];
#pragma unroll
        for (int u = 0; u < 4; ++u) w[u] = *(const v2u*)(QK + ((size_t)(it0 + u) * 2 + (lane >> 5)) * 128 + e0);
#pragma unroll
        for (int u = 0; u < 4; ++u) { const float x0 = bflo(w[u].x), x1 = bfhi(w[u].x), x2 = bflo(w[u].y), x3 = bfhi(w[u].y); ss[u] = (x0 * x0 + x1 * x1) + (x2 * x2 + x3 * x3); }
#pragma unroll
        for (int o = 1; o < 32; o <<= 1) {
#pragma unroll
            for (int u = 0; u < 4; ++u) ss[u] += __shfl_xor(ss[u], o); }
#pragma unroll
        for (int u = 0; u < 4; ++u) {
            const size_t r = (size_t)(it0 + u) * 2 + (lane >> 5); const int tensor = (int)(r >> 17);
            const v4f g = *(const v4f*)((tensor ? p.in[5] : p.in[4]) + e0);
            const float x0 = bflo(w[u].x), x1 = bfhi(w[u].x), x2 = bflo(w[u].y), x3 = bfhi(w[u].y);
            const float rs = __builtin_amdgcn_rsqf(ss[u] * (1.f / 128.f) + EPS) * (tensor ? 1.f : 0.12751743082459868f);
            v2u o2; o2.x = cvtpk(x0 * rs * g[0], x1 * rs * g[1]); o2.y = cvtpk(x2 * rs * g[2], x3 * rs * g[3]);
            *(v2u*)(QK + r * 128 + e0) = o2;
        }
    }
}
struct EpiRes {
    static constexpr bool PERM = false, AFTER_DRAIN = false;
    const float* base; float* out; u16* xb; float* ssq;
    __device__ __forceinline__ void operator()(const pg8::f32x4 (&acc)[2][2][4][2], const pg8::Unit& u, int wr, int wc, int fr, int fq) const {
        asm volatile("" : "+v"(fr), "+v"(fq));
        const int col0 = u.pn * 256 + wc * 32 + 4 * fq;
#pragma unroll
        for (int ai = 0; ai < 2; ++ai)
#pragma unroll
            for (int m = 0; m < 4; ++m) {
                const size_t row = (size_t)u.pm * 256 + ai * 128 + wr * 64 + m * 16 + fr; const size_t off = row * DM + col0; float s = 0.f;
#pragma unroll
                for (int bj = 0; bj < 2; ++bj)
#pragma unroll
                    for (int n = 0; n < 2; ++n) {
                        const size_t o = off + bj * 128 + n * 16;
                        const v4f bs = *(const v4f*)(base + o); const pg8::f32x4 a = acc[ai][bj][m][n];
                        v4f v; v[0] = bs[0] + a[0]; v[1] = bs[1] + a[1]; v[2] = bs[2] + a[2]; v[3] = bs[3] + a[3];
                        *(v4f*)(out + o) = v;
                        if (xb) { v2u w; w.x = cvtpk(v[0], v[1]); w.y = cvtpk(v[2], v[3]); *(v2u*)(xb + o) = w; }
                        s += (v[0] * v[0] + v[1] * v[1]) + (v[2] * v[2] + v[3] * v[3]);
                    }
                if (ssq) { s += __shfl_xor(s, 16); s += __shfl_xor(s, 32); if (fq == 0) ssq[((size_t)u.pn * S_ + row) * 4 + wc] = s; }
            }
    }
};
struct EpiScale {
    static constexpr bool PERM = true, AFTER_DRAIN = false;
    const float* ssq; u16* O0; int ld0; int n0;
    u16* O1; int ld1; int n1;
    float* O2; int ld2; int n2;
    __device__ __forceinline__ void operator()(const pg8::f32x4 (&acc)[2][2][4][2], const pg8::Unit& u, int wr, int wc, int fr, int fq) const {
        asm volatile("" : "+v"(fr), "+v"(fq));
        const int colt = u.pn * 256; const int cl = wc * 32 + fq * 8;
#pragma unroll
        for (int ai = 0; ai < 2; ++ai)
#pragma unroll
            for (int m = 0; m < 4; ++m) {
                const size_t row = (size_t)u.pm * 256 + ai * 128 + wr * 64 + m * 16 + fr;
                float sq = 0.f;
#pragma unroll
                for (int t = 0; t < 8; ++t) { const v4f q4 = *(const v4f*)(ssq + ((size_t)t * S_ + row) * 4); sq += (q4[0] + q4[1]) + (q4[2] + q4[3]); }
                const float rs = __builtin_amdgcn_rsqf(sq * (1.f / 2048.f) + EPS);
#pragma unroll
                for (int bj = 0; bj < 2; ++bj) {
                    const int col = colt + bj * 128 + cl;
                    const pg8::f32x4 a = acc[ai][bj][m][0], b = acc[ai][bj][m][1];
                    if (colt < n1) {
                        v4u w; w.x = cvtpk(a[0] * rs, a[1] * rs); w.y = cvtpk(a[2] * rs, a[3] * rs); w.z = cvtpk(b[0] * rs, b[1] * rs); w.w = cvtpk(b[2] * rs, b[3] * rs);
                        if (colt < n0) *(v4u*)(O0 + row * ld0 + col) = w; else *(v4u*)(O1 + row * ld1 + (col - n0)) = w;
                    } else if (col < n2) {
                        float* p = O2 + row * ld2 + (col - n1);
                        v4f x = {a[0] * rs, a[1] * rs, a[2] * rs, a[3] * rs}, y = {b[0] * rs, b[1] * rs, b[2] * rs, b[3] * rs};
                        *(v4f*)p = x; *(v4f*)(p + 4) = y;
                    }
                }
            }
    }
};

__device__ __forceinline__ void transpose_item(const float* W, int K, int N, u16* WT, const float* gain, LAS float* scr, int item, int lane) {
    const int nblk = N / 32, kb = item / nblk, nb = item % nblk, k0 = 64 * kb, n0 = 32 * nb;
    float tv[32];
#pragma unroll
    for (int i = 0; i < 32; ++i) tv[i] = W[(size_t)(k0 + 2 * i + (lane >> 5)) * N + n0 + (lane & 31)];
#pragma unroll
    for (int i = 0; i < 32; ++i) { const int kk = 2 * i + (lane >> 5); float v = tv[i]; if (gain) v *= gain[k0 + kk]; scr[kk * 33 + (lane & 31)] = v; }
    LDS_WAIT(); asm volatile("" ::: "memory");
    const int c = lane & 7;
#pragma unroll
    for (int j = 0; j < 4; ++j) { const int n = (lane >> 3) + 8 * j; const LAS float* s = scr + (8 * c) * 33 + n;
        v4u o; o.x = cvtpk(s[0 * 33], s[1 * 33]); o.y = cvtpk(s[2 * 33], s[3 * 33]); o.z = cvtpk(s[4 * 33], s[5 * 33]); o.w = cvtpk(s[6 * 33], s[7 * 33]);
        *(v4u*)(WT + (size_t)(n0 + n) * K + k0 + 8 * c) = o; }
    LDS_WAIT(); asm volatile("" ::: "memory");
}

__device__ __forceinline__ void phase_p0(const Params& p, LAS unsigned char* lds) {
    const int tid = otid(), lane = tid & 63, wave = tid >> 6;
    LAS float* scr = (LAS float*)(lds + wave * 16384);
    const int gw = blockIdx.x * 8 + wave, NGW = gridDim.x * 8;
    unsigned char* ws = p.ws;
    constexpr int I_QKV = 32 * 192, I_O = 32 * 64, I_UP = 32 * 344, I_DN = 86 * 64, I_IN = 32 * 386, I_OUT = 64 * 64;
    constexpr int NIT = I_QKV + I_O + I_UP + I_DN + I_IN;
    (void)I_OUT;
    for (int it = gw; it < NIT; it += NGW) {
        int r = it;
        if (r < I_QKV) { transpose_item(p.in[3], DM, NQKV, (u16*)(ws + WS_WQKV), nullptr, scr, r, lane); continue; } r -= I_QKV;
        if (r < I_O) { transpose_item(p.in[11], DM, DM, (u16*)(ws + WS_WO), nullptr, scr, r, lane); continue; } r -= I_O;
        if (r < I_UP) { transpose_item(p.in[18], DM, NUP, (u16*)(ws + WS_WUP0), p.in[2], scr, r, lane); continue; } r -= I_UP;
        if (r < I_DN) { transpose_item(p.in[21], DFF, DM, (u16*)(ws + WS_WDN0), nullptr, scr, r, lane); continue; } r -= I_DN;
        transpose_item(p.in[12], DM, GIN, (u16*)(ws + WS_WIN), p.in[1] + DM, scr, r, lane);
    }
    { const size_t gt = (size_t)blockIdx.x * 512 + tid, NT = (size_t)gridDim.x * 512;
      v4u z = {0u, 0u, 0u, 0u}; v4u* pz = (v4u*)(ws + WS_WIN + (size_t)GIN * DM * 2);
      for (size_t i = gt; i < (size_t)(GINP - GIN) * DM * 2 / 16; i += NT) pz[i] = z;
    }
    if (blockIdx.x == 0 && tid < 16) ((unsigned*)(ws + WS_MISC))[tid] = 0u;
    const float* x = p.in[0]; const float* g = p.in[1]; u16* xb = (u16*)(ws + WS_XB);
    for (int row = gw; row < S_; row += NGW) {
        const v4f* xr = (const v4f*)(x + (size_t)row * DM) + lane; v4f v[8]; float s = 0.f;
#pragma unroll
        for (int j = 0; j < 8; ++j) { v[j] = xr[64 * j]; s += (v[j][0] * v[j][0] + v[j][1] * v[j][1]) + (v[j][2] * v[j][2] + v[j][3] * v[j][3]); }
        const float rs = __builtin_amdgcn_rsqf(wave_sum(s) * (1.f / DM) + EPS);
#pragma unroll
        for (int j = 0; j < 8; ++j) { const v4f gg = *((const v4f*)g + lane + 64 * j);
            v2u w; w.x = cvtpk(v[j][0] * rs * gg[0], v[j][1] * rs * gg[1]); w.y = cvtpk(v[j][2] * rs * gg[2], v[j][3] * rs * gg[3]);
            *((v2u*)(xb + (size_t)row * DM) + lane + 64 * j) = w; }
    }
}

__device__ __forceinline__ void phase_p0_late(const Params& p, LAS unsigned char* lds, int widx, int nw) {
    const int tid = otid(), lane = tid & 63, wave = tid >> 6;
    LAS float* scr = (LAS float*)(lds + wave * 16384);
    unsigned char* ws = p.ws;
    constexpr int I_UP = 32 * 344, I_DN = 86 * 64, I_OUT = 64 * 64;
    for (int it = widx * 8 + wave; it < I_UP + I_DN + I_OUT; it += nw * 8) {
        int r = it;
        if (r < I_UP) { transpose_item(p.in[18] + (size_t)DM * NUP, DM, NUP, (u16*)(ws + WS_WUP1), p.in[2] + DM, scr, r, lane); continue; } r -= I_UP;
        if (r < I_DN) { transpose_item(p.in[21] + (size_t)DFF * DM, DFF, DM, (u16*)(ws + WS_WDN1), nullptr, scr, r, lane); continue; } r -= I_DN;
        transpose_item(p.in[17], GV, DM, (u16*)(ws + WS_WOUT), nullptr, scr, r, lane);
    }
}
__device__ __forceinline__ att::BlockRef<att::bf16, float> attn_ref(int m32, int qb, const u16* Qh, const u16* Kh, const u16* Vh, float* O, const char* ldsb) {
    const int map = m32 >> 1, c = m32 & 1, h = map >> 1;
    const float wnum = __int_as_float(__builtin_amdgcn_readfirstlane(*(const LAS int*)((const LAS char*)ldsb + 68608)));
    att::BlockRef<att::bf16, float> r;
    r.Q = (const att::bf16*)(Qh + ((size_t)map * S_ + (size_t)qb * 256) * 128);
    r.K = (const att::bf16*)(Kh + (size_t)map * S_ * 128);
    r.V = (const att::bf16*)(Vh + (size_t)(h * 2 + c) * S_ * 128);
    r.O = O + ((size_t)m32 * S_ + (size_t)qb * 256) * 128;
    const float slope = __builtin_amdgcn_exp2f(-(float)(h + 1));
    int jlo = 0;
#if MK_ATT_WINDOW && !MK_HYBRID
    { const float wf = wnum / slope + 65.f; const int W = wf < 1.0e9f ? (int)wf : (1 << 30); const int lowk = qb * 256 - W + 1; jlo = lowk > 0 ? lowk / 256 : 0; }
#endif
    r.K += (size_t)jlo * 256 * 128; r.V += (size_t)jlo * 256 * 128;
    r.P0 = (qb - jlo) * 256; r.W = 1 << 30;
    r.nsl = -slope * 1.4426950408889634f;
    return r;
}
struct AttItem { int m32, qb0, qb1; };
__device__ __forceinline__ AttItem attn_decode(int L) {
    const int xcd = L & 7, k = L >> 3, gi = k >> 4, r = k & 15; AttItem it;
    it.m32 = (xcd + 8 * (gi >> 1)) * 2 + (gi & 1); it.qb0 = r; it.qb1 = 31 - r; return it;
}
__device__ __forceinline__ void phase_attn(const Params& p, char* lds) {
    const u16* Qh = (const u16*)(p.ws + WS_QH); const u16* Kh = (const u16*)(p.ws + WS_KH); const u16* Vh = (const u16*)(p.ws + WS_VH); float* O = (float*)(p.ws + WS_OATT);
    constexpr int total = 512; const int stride = gridDim.x;
    int L = blockIdx.x; if (L >= total) return;
    float wnum;
    { const int lane = otid() & 63;
      float mq = fmaxf(__builtin_fabsf(p.in[4][lane]), __builtin_fabsf(p.in[4][lane + 64])), mk = fmaxf(__builtin_fabsf(p.in[5][lane]), __builtin_fabsf(p.in[5][lane + 64]));
#pragma unroll
      for (int o = 1; o < 64; o <<= 1) { mq = fmaxf(mq, __shfl_xor(mq, o)); mk = fmaxf(mk, __shfl_xor(mk, o)); }
      wnum = 104.f + 2.f * 1.02f * 11.313708498984761f * mq * mk;
      if (otid() == 0) *(LAS float*)((LAS char*)lds + 68608) = wnum; }
    __syncthreads();
    AttItem it = attn_decode(L); int pass = 0;
    att::BlockRef<att::bf16, float> cur = attn_ref(it.m32, it.qb0, Qh, Kh, Vh, O, lds);
    att::Seam<att::bf16> S;
    att::causal_swa_prime<att::bf16, float>(cur, lds, S);
    for (;;) {
        const bool more_pass = pass == 0, more_item = L + stride < total, last = !more_pass && !more_item;
        AttItem itn = it; int passn = pass + 1, Ln = L;
        if (!more_pass) { passn = 0; Ln = more_item ? L + stride : L; itn = attn_decode(Ln); }
        const att::BlockRef<att::bf16, float> nxt = last ? cur : attn_ref(itn.m32, passn ? itn.qb1 : itn.qb0, Qh, Kh, Vh, O, lds);
        att::causal_swa_block<att::bf16, float>(cur, nxt, S_, lds, S);
        if (last) break;
        cur = nxt; it = itn; pass = passn; L = Ln;
    }
}
__device__ __forceinline__ void phase_combine(const Params& p) {
    const int tid = otid(), lane = tid & 63, wave = tid >> 6;
    const int gw = blockIdx.x * 8 + wave, NGW = gridDim.x * 8;
    float s1 = p.in[6][lane] * p.in[7][lane] + p.in[6][lane + 64] * p.in[7][lane + 64];
    float s2 = p.in[8][lane] * p.in[9][lane] + p.in[8][lane + 64] * p.in[9][lane + 64];
    s1 = wave_sum(s1); s2 = wave_sum(s2);
    const float lam = __expf(s1) - __expf(s2) + 0.2f;
    const float* O = (const float*)(p.ws + WS_OATT); u16* OB = (u16*)(p.ws + WS_OB);
    const int e0 = 4 * lane, c = e0 >> 7, wi = e0 & 127;
    const v4f sg = *(const v4f*)(p.in[10] + e0);
    for (int it0 = gw * 4; it0 < S_ * 8; it0 += NGW * 4) {
        v4f a[4], b[4], v[4]; float ss[4];
#pragma unroll
        for (int u = 0; u < 4; ++u) { const int it = it0 + u, t = it >> 3, h = it & 7;
            a[u] = *(const v4f*)(O + ((size_t)((4 * h + c)) * S_ + t) * 128 + wi);
            b[u] = *(const v4f*)(O + ((size_t)((4 * h + 2 + c)) * S_ + t) * 128 + wi); }
#pragma unroll
        for (int u = 0; u < 4; ++u) { v[u][0] = a[u][0] - lam * b[u][0]; v[u][1] = a[u][1] - lam * b[u][1]; v[u][2] = a[u][2] - lam * b[u][2]; v[u][3] = a[u][3] - lam * b[u][3];
            ss[u] = (v[u][0] * v[u][0] + v[u][1] * v[u][1]) + (v[u][2] * v[u][2] + v[u][3] * v[u][3]); }
#pragma unroll
        for (int o = 1; o < 64; o <<= 1) {
#pragma unroll
            for (int u = 0; u < 4; ++u) ss[u] += __shfl_xor(ss[u], o); }
#pragma unroll
        for (int u = 0; u < 4; ++u) { const int it = it0 + u, t = it >> 3, h = it & 7;
            const float rs = __builtin_amdgcn_rsqf(ss[u] * (1.f / 256.f) + EPS) * 0.8f;
            v2u w; w.x = cvtpk(v[u][0] * rs * sg[0], v[u][1] * rs * sg[1]); w.y = cvtpk(v[u][2] * rs * sg[2], v[u][3] * rs * sg[3]);
            *(v2u*)(OB + (size_t)t * DM + h * 256 + e0) = w; }
    }
}

__device__ __forceinline__ void unpack8(const v4u w, float (&f)[8]) { f[0] = bflo(w.x); f[1] = bfhi(w.x); f[2] = bflo(w.y); f[3] = bfhi(w.y); f[4] = bflo(w.z); f[5] = bfhi(w.z); f[6] = bflo(w.w); f[7] = bfhi(w.w); }
__device__ __forceinline__ void phase_convgate(const Params& p, int layer) {
    const u16* U = (const u16*)(p.ws + WS_U); u16* Y = (u16*)(p.ws + WS_Y);
    const float* cw = p.in[19] + (size_t)layer * 3 * NUP; const float* cb = p.in[20] + (size_t)layer * NUP;
    constexpr int NCG = DFF / 8, RUN = 16, NRUN = S_ / RUN;
    const size_t gt = (size_t)blockIdx.x * 512 + otid(), NT = (size_t)gridDim.x * 512;
    for (size_t idx = gt; idx < (size_t)NCG * NRUN; idx += NT) {
        const int cg8 = (int)(idx % NCG) * 8, t0 = (int)(idx / NCG) * RUN;
        float wv[3][8], wg[3][8], bv[8], bg[8];
#pragma unroll
        for (int j = 0; j < 3; ++j)
#pragma unroll
            for (int e = 0; e < 8; ++e) { wv[j][e] = cw[j * NUP + cg8 + e]; wg[j][e] = cw[j * NUP + DFF + cg8 + e]; }
#pragma unroll
        for (int e = 0; e < 8; ++e) { bv[e] = cb[cg8 + e]; bg[e] = cb[DFF + cg8 + e]; }
        float v2[8], v1[8], g2[8], g1[8];
#pragma unroll
        for (int e = 0; e < 8; ++e) { v2[e] = v1[e] = g2[e] = g1[e] = 0.f; }
        if (t0 >= 2) {
            unpack8(*(const v4u*)(U + (size_t)(t0 - 2) * NUP + cg8), v2); unpack8(*(const v4u*)(U + (size_t)(t0 - 1) * NUP + cg8), v1);
            unpack8(*(const v4u*)(U + (size_t)(t0 - 2) * NUP + DFF + cg8), g2); unpack8(*(const v4u*)(U + (size_t)(t0 - 1) * NUP + DFF + cg8), g1);
        }
#pragma unroll
        for (int t = t0; t < t0 + RUN; ++t) {
            float v0[8], g0[8];
            unpack8(*(const v4u*)(U + (size_t)t * NUP + cg8), v0); unpack8(*(const v4u*)(U + (size_t)t * NUP + DFF + cg8), g0);
            float y[8];
#pragma unroll
            for (int e = 0; e < 8; ++e) {
                const float val = wv[0][e] * v2[e] + wv[1][e] * v1[e] + wv[2][e] * v0[e] + bv[e];
                const float gat = wg[0][e] * g2[e] + wg[1][e] * g1[e] + wg[2][e] * g0[e] + bg[e];
                y[e] = silu_f(gat) * val; v2[e] = v1[e]; v1[e] = v0[e]; g2[e] = g1[e]; g1[e] = g0[e];
            }
            v4u w = {cvtpk(y[0], y[1]), cvtpk(y[2], y[3]), cvtpk(y[4], y[5]), cvtpk(y[6], y[7])};
            *(v4u*)(Y + (size_t)t * DFF + cg8) = w;
        }
    }
}

__device__ __forceinline__ int crow(int r, int hi) { return (r & 3) + 8 * (r >> 2) + 4 * hi; }
__device__ __forceinline__ v16f mm_tile(v16f c, const LAS u16* A, int lda, const LAS u16* Bt, int ldb, int K, int lane) {
    const int m = lane & 31, hi = lane >> 5;
    for (int k0 = 0; k0 < K; k0 += 16) {
        const v8s a = *(const LAS v8s*)(A + m * lda + k0 + 8 * hi); const v8s b = *(const LAS v8s*)(Bt + m * ldb + k0 + 8 * hi);
        c = __builtin_amdgcn_mfma_f32_32x32x16_bf16(a, b, c, 0, 0, 0);
    }
    return c;
}
__device__ __forceinline__ void phase_ba(const Params& p, LAS unsigned char* lds) {
    const int tid = otid(), lane = tid & 63, wave = __builtin_amdgcn_readfirstlane(tid >> 6), m = lane & 31, hi = lane >> 5;
    const u16* XBp = (const u16*)(p.ws + WS_XB); const u16* Wb = (const u16*)(p.ws + WS_WIN) + (size_t)12288 * DM;
    const float* ssq = (const float*)(p.ws + WS_SSQ) + 32 * S_; float* BA = (float*)(p.ws + WS_BA);
    LAS float* red = (LAS float*)lds;
    for (int b = blockIdx.x; b < S_ / 32; b += gridDim.x) {
        __syncthreads();
        v16f c0, c1;
#pragma unroll
        for (int r = 0; r < 16; ++r) { c0[r] = 0.f; c1[r] = 0.f; }
        const u16* ap = XBp + (size_t)(32 * b + m) * DM + wave * 256 + 8 * hi;
        const u16* b0p = Wb + (size_t)m * DM + wave * 256 + 8 * hi; const u16* b1p = b0p + (size_t)32 * DM;
#pragma unroll
        for (int half = 0; half < 2; ++half) {
            v8s af[8], bf0[8], bf1[8];
#pragma unroll
            for (int k = 0; k < 8; ++k) { const int ko = (half * 8 + k) * 16; af[k] = *(const v8s*)(ap + ko); bf0[k] = *(const v8s*)(b0p + ko); bf1[k] = *(const v8s*)(b1p + ko); }
#pragma unroll
            for (int k = 0; k < 8; ++k) { c0 = __builtin_amdgcn_mfma_f32_32x32x16_bf16(af[k], bf0[k], c0, 0, 0, 0); c1 = __builtin_amdgcn_mfma_f32_32x32x16_bf16(af[k], bf1[k], c1, 0, 0, 0); }
        }
#pragma unroll
        for (int r = 0; r < 16; ++r) { red[((wave * 2 + 0) * 64 + lane) * 16 + r] = c0[r]; red[((wave * 2 + 1) * 64 + lane) * 16 + r] = c1[r]; }
        __syncthreads();
        for (int e = tid; e < 2 * 64 * 16; e += 512) {
            const int j = e >> 10, l = (e >> 4) & 63, r = e & 15;
            float s = 0.f;
#pragma unroll
            for (int w = 0; w < 8; ++w) s += red[((w * 2 + j) * 64 + l) * 16 + r];
            const int row = 32 * b + crow(r, l >> 5), col = 32 * j + (l & 31);
            float sq = 0.f;
#pragma unroll
            for (int t = 0; t < 8; ++t) { const v4f q4 = *(const v4f*)(ssq + ((size_t)t * S_ + row) * 4); sq += (q4[0] + q4[1]) + (q4[2] + q4[3]); }
            BA[(size_t)row * 64 + col] = s * __builtin_amdgcn_rsqf(sq * (1.f / 2048.f) + EPS);
        }
    }
}
constexpr int PL_KB = 0, PL_QB = 17408, PL_KK = 34816, PL_QK = 51456, PL_GT = 68096, PL_HD = 69632;
constexpr int PL_KBE = PL_HD, PL_VBT = PL_HD + 18432, PL_PB = PL_HD + 36864, PL_PBT = PL_HD + 46080, PL_TB = PL_HD + 55296;
constexpr int PL_XQ = PL_HD, PL_XK = PL_HD + 33024;
static_assert(PL_XK + 33024 <= LDS_BYTES, "prep LDS");

template <bool FROM_S, int HQ_LIM> __device__ __forceinline__ void phase_gdn_prep(const Params& p, LAS unsigned char* lds) {
    const int tid = otid(), lane = tid & 63, wave = __builtin_amdgcn_readfirstlane(tid >> 6), n = lane & 31, hi = lane >> 5;
    const u16* PQ = (const u16*)(p.ws + WS_PQKV); const float* BA = (const float*)(p.ws + WS_BA);
    unsigned char* OPS = p.ws + (FROM_S ? WS_OPS_H : WS_OPS);
    const float* cw = p.in[13];
    const float* SQ = (const float*)(p.ws + WS_SQ); const float* SK = (const float*)(p.ws + WS_SK); const float* SV = (const float*)(p.ws + WS_SV); const float* SG = (const float*)(p.ws + WS_SG);
    LAS u16* Kb = (LAS u16*)(lds + PL_KB); LAS u16* Qb = (LAS u16*)(lds + PL_QB);
    LAS float* KKf = (LAS float*)(lds + PL_KK); LAS float* QKf = (LAS float*)(lds + PL_QK);
    LAS float* beta = (LAS float*)(lds + PL_GT); LAS float* gc = beta + 128; LAS float* rsq = beta + 256;
    LAS u16* KbeT = (LAS u16*)(lds + PL_KBE); LAS u16* VbT = (LAS u16*)(lds + PL_VBT);
    LAS float* Lf = (LAS float*)(lds + PL_PB); LAS u16* Tb = (LAS u16*)(lds + PL_TB);
    LAS float* Xq = (LAS float*)(lds + PL_XQ); LAS float* Xk = (LAS float*)(lds + PL_XK);
    for (int item = blockIdx.x; item < HQ_LIM * 128; item += gridDim.x) {
        const int hq = item >> 7, ch = item & 127, t0 = ch * 64;
        __syncthreads();
      if constexpr (FROM_S) {
        if (tid < 128) {
            const int hvl = tid >> 6, hv = 2 * hq + hvl, tok = tid & 63;
            float g = SG[((size_t)(t0 + tok) * 32 + hv) * 2]; const float be = SG[((size_t)(t0 + tok) * 32 + hv) * 2 + 1];
#pragma unroll
            for (int o = 1; o < 64; o <<= 1) { const float t = __shfl_up(g, o); if (tok >= o) g += t; }
            beta[hvl * 64 + tok] = be; gc[hvl * 64 + tok] = g;
            if (tok == 63) *(float*)(OPS + (size_t)(hv * 128 + ch) * OPS_BLK + OP_GL) = __expf(g);
        }
        for (int i = tid; i < 2 * 64 * 128; i += 512) {
            const int which = i >> 13, tok = (i >> 7) & 63, c = i & 127;
            (which ? Kb : Qb)[tok * 136 + c] = f2bf((which ? SK : SQ)[(size_t)(t0 + tok) * 2048 + hq * 128 + c]);
        }
        __syncthreads();
      } else {
        if (tid < 128) {
            const int hvl = tid >> 6, hv = 2 * hq + hvl, tok = tid & 63;
            const float b = BA[(size_t)(t0 + tok) * 64 + hv], a = BA[(size_t)(t0 + tok) * 64 + 32 + hv];
            const float be = 1.f / (1.f + __expf(-b));
            const float xs = a + p.in[15][hv];
            const float sp = xs > 20.f ? xs : log1pf(__expf(xs));
            float g = -__expf(p.in[14][hv]) * sp;
#pragma unroll
            for (int o = 1; o < 64; o <<= 1) { const float t = __shfl_up(g, o); if (tok >= o) g += t; }
            beta[hvl * 64 + tok] = be; gc[hvl * 64 + tok] = g;
            if (tok == 63) *(float*)(OPS + (size_t)(hv * 128 + ch) * OPS_BLK + OP_GL) = __expf(g);
        }
        {
            const int cc = tid & 255, half = tid >> 8;
            const int col = cc < 128 ? hq * 128 + cc : 2048 + hq * 128 + (cc - 128);
            const float w0 = cw[col], w1 = cw[8192 + col], w2 = cw[2 * 8192 + col], w3 = cw[3 * 8192 + col];
            const int ts = t0 + 32 * half;
            u16 xr[35];
#pragma unroll
            for (int t = 0; t < 35; ++t) { const int tt = ts - 3 + t; xr[t] = PQ[(size_t)(tt < 0 ? 0 : tt) * 8192 + col]; }
            LAS float* X = cc < 128 ? Xq : Xk; const int c7 = cc & 127;
            float x0 = ts >= 3 ? bf2f(xr[0]) : 0.f, x1 = ts >= 3 ? bf2f(xr[1]) : 0.f, x2 = ts >= 3 ? bf2f(xr[2]) : 0.f;
#pragma unroll
            for (int t = 0; t < 32; ++t) {
                const float x3 = bf2f(xr[t + 3]);
                const float y = w0 * x0 + w1 * x1 + w2 * x2 + w3 * x3;
                X[(32 * half + t) * 129 + c7] = silu_f(y); x0 = x1; x1 = x2; x2 = x3;
            }
        }
        __syncthreads();
        {
            const int idx = tid >> 2, pq = tid & 3, which = idx >> 6, tok = idx & 63; const LAS float* X = (which ? Xk : Xq) + tok * 129 + pq; float s = 0.f;
#pragma unroll 8
            for (int c = 0; c < 128; c += 4) s += X[c] * X[c];
            s += dpp_f<0xB1>(s); s += dpp_f<0x4E>(s);
            if (pq == 0) rsq[idx] = __builtin_amdgcn_rsqf(s + EPS) * (which ? 1.f : 0.08838834764831845f);
        }
        __syncthreads();
        for (int i = tid; i < 2 * 64 * 128; i += 512) {
            const int which = i >> 13, tok = (i >> 7) & 63, c = i & 127;
            const float v = (which ? Xk : Xq)[tok * 129 + c] * rsq[which * 64 + tok];
            (which ? Kb : Qb)[tok * 136 + c] = f2bf(v);
        }
        __syncthreads();
      }
        {
            const int ti = (wave >> 1) & 1, tj = wave & 1; v16f c = {};
            c = mm_tile(c, (wave < 4 ? Kb : Qb) + 32 * ti * 136, 136, Kb + 32 * tj * 136, 136, 128, lane);
            LAS float* D = wave < 4 ? KKf : QKf;
#pragma unroll
            for (int r = 0; r < 16; ++r) D[(32 * ti + crow(r, hi)) * 65 + 32 * tj + n] = c[r];
        }
        __syncthreads();
      if constexpr (FROM_S) {
        for (int hvl = 0; hvl < 2; ++hvl) {
            const int hv = 2 * hq + hvl;
            const LAS float* be = beta + hvl * 64; const LAS float* g = gc + hvl * 64;
            unsigned char* ob = OPS + (size_t)(hv * 128 + ch) * OPS_BLK;
            if constexpr (FROM_S) {
                for (int i = tid; i < 64 * 128; i += 512) { const int tok = i >> 7, c = i & 127; VbT[c * 72 + tok] = f2bf(SV[(size_t)(t0 + tok) * 4096 + hv * 128 + c]); }
            } else {
                const int c = tid & 127, q4 = tid >> 7, col = 4096 + hv * 128 + c;
                const float w0 = cw[col], w1 = cw[8192 + col], w2 = cw[2 * 8192 + col], w3 = cw[3 * 8192 + col];
                const int ts = t0 + 16 * q4;
                u16 xr[19];
#pragma unroll
                for (int t = 0; t < 19; ++t) { const int tt = ts - 3 + t; xr[t] = PQ[(size_t)(tt < 0 ? 0 : tt) * 8192 + col]; }
                float x0 = ts >= 3 ? bf2f(xr[0]) : 0.f, x1 = ts >= 3 ? bf2f(xr[1]) : 0.f, x2 = ts >= 3 ? bf2f(xr[2]) : 0.f;
#pragma unroll
                for (int t = 0; t < 16; ++t) {
                    const float x3 = bf2f(xr[t + 3]);
                    const float y = w0 * x0 + w1 * x1 + w2 * x2 + w3 * x3; const int tok = 16 * q4 + t;
                    VbT[c * 72 + tok] = f2bf(be[tok] * silu_f(y)); x0 = x1; x1 = x2; x2 = x3;
                }
            }
            for (int i = tid; i < 128 * 64; i += 512) { const int d = i >> 6, tok = i & 63; KbeT[d * 72 + tok] = f2bf(bf2f(Kb[tok * 136 + d]) * be[tok] * __expf(g[tok])); }
            for (int e = tid; e < 64 * 64; e += 512) {
                const int i = e >> 6, j = e & 63;
                Lf[i * 64 + j] = j < i ? be[i] * KKf[i * 65 + j] * __expf(g[i] - g[j]) : 0.f;
            }
            __syncthreads();
            if (wave == 0) {
                float tc[64];
                int lane_o = lane; asm volatile("" : "+v"(lane_o));
                unsigned lbase = (unsigned)(uintptr_t)Lf; asm volatile("" : "+v"(lbase));
                const LAS float* Lp = (const LAS float*)(uintptr_t)lbase;
                float Lr[64];
#pragma unroll
                for (int i = 0; i < 64; ++i) Lr[i] = Lp[i * 64 + lane_o];
#pragma unroll
                for (int i = 0; i < 64; ++i) {
                    float acc = (lane_o == i) ? 1.f : 0.f;
#pragma unroll
                    for (int j = 0; j < i; ++j) acc -= __int_as_float(__builtin_amdgcn_readlane(__float_as_int(Lr[i]), j)) * tc[j];
                    tc[i] = acc;
                }
#pragma unroll
                for (int i = 0; i < 64; ++i) Tb[i * 72 + lane] = f2bf(tc[i]);
            }
#if MK_CHECK == 2
            __syncthreads();
            if (wave == 1) { LAS u16* Ib = (LAS u16*)Lf; for (int i = 0; i < 64; ++i) Ib[i * 72 + lane] = (lane == i) ? (u16)0x3f80 : (u16)0; }
#endif
            __syncthreads();
            {
                const int mt = wave >> 2, nt = wave & 3; v16f c = {};
#if MK_CHECK == 2
                c = mm_tile(c, (LAS u16*)Lf + 32 * mt * 72, 72, VbT + 32 * nt * 72, 72, 64, lane);
#else
                c = mm_tile(c, Tb + 32 * mt * 72, 72, VbT + 32 * nt * 72, 72, 64, lane);
#endif
                v8s lo = pack8f(c[0], c[1], c[2], c[3], c[4], c[5], c[6], c[7]), hi8 = pack8f(c[8], c[9], c[10], c[11], c[12], c[13], c[14], c[15]);
                unsigned char* d = ob + OP_U + nt * 4096 + (mt * 64 + lane) * 32;
                *(v8s*)d = lo; *(v8s*)(d + 16) = hi8;
            }
            {
                const int t = wave >> 1, mt = wave & 1; v16f c = {};
                c = mm_tile(c, KbeT + 32 * t * 72, 72, Tb + 32 * mt * 72, 72, 64, lane);
                v8s lo = pack8f(-c[0], -c[1], -c[2], -c[3], -c[4], -c[5], -c[6], -c[7]), hi8 = pack8f(-c[8], -c[9], -c[10], -c[11], -c[12], -c[13], -c[14], -c[15]);
                *(v8s*)(ob + OP_W + (mt * 8 + 2 * t) * 1024 + lane * 16) = lo;
                *(v8s*)(ob + OP_W + (mt * 8 + 2 * t + 1) * 1024 + lane * 16) = hi8;
            }
            for (int task = tid; task < 1024; task += 512) {
                const int f = task >> 6, l = task & 63, m = l & 31, h2 = l >> 5, mi = f >> 3, ks = f & 7;
                const int tok = 32 * mi + m, d0 = 16 * ks + 4 * h2; const float eg = __expf(g[tok]);
                const LAS u16* q = Qb + tok * 136 + d0;
                *(v8s*)(ob + OP_QD + f * 1024 + l * 16) = pack8f(bf2f(q[0]) * eg, bf2f(q[1]) * eg, bf2f(q[2]) * eg, bf2f(q[3]) * eg, bf2f(q[8]) * eg, bf2f(q[9]) * eg, bf2f(q[10]) * eg, bf2f(q[11]) * eg);
            }
            {
                const float g63 = g[63];
                for (int task = tid; task < 1024; task += 512) {
                    const int f = task >> 6, l = task & 63, m = l & 31, h2 = l >> 5, t = f >> 2, ks = f & 3;
                    const int tk0 = 16 * ks + 4 * h2, d = 32 * t + m; float v[8];
#pragma unroll
                    for (int j = 0; j < 8; ++j) { const int tok = tk0 + (j & 3) + 8 * (j >> 2); v[j] = bf2f(Kb[tok * 136 + d]) * __expf(g63 - g[tok]); }
                    *(v8s*)(ob + OP_KD + f * 1024 + l * 16) = pack8f(v[0], v[1], v[2], v[3], v[4], v[5], v[6], v[7]);
                }
            }
            {
                const int f = tid >> 6, l = tid & 63, m = l & 31, h2 = l >> 5, mi = f >> 2, ks = f & 3;
                const int i = 32 * mi + m, tk0 = 16 * ks + 4 * h2; const float gi = g[i]; float v[8];
#pragma unroll
                for (int j = 0; j < 8; ++j) { const int tok = tk0 + (j & 3) + 8 * (j >> 2); v[j] = tok <= i ? QKf[i * 65 + tok] * __expf(gi - g[tok]) : 0.f; }
                *(v8s*)(ob + OP_QK + f * 1024 + l * 16) = pack8f(v[0], v[1], v[2], v[3], v[4], v[5], v[6], v[7]);
            }
            __syncthreads();
        }
      } else {
#define P2_FILL_L(hvl_) do { const LAS float* be_ = beta + (hvl_) * 64; const LAS float* g_ = gc + (hvl_) * 64; \
            for (int e = tid; e < 64 * 64; e += 512) { const int i = e >> 6, j = e & 63; Lf[i * 64 + j] = j < i ? be_[i] * KKf[i * 65 + j] * __expf(g_[i] - g_[j]) : 0.f; } } while (0)
#define P2_LOAD_L() do { unsigned lb_ = (unsigned)(uintptr_t)Lf; asm volatile("" : "+v"(lb_)); const LAS float* Lp_ = (const LAS float*)(uintptr_t)lb_; \
            _Pragma("unroll") for (int i = 0; i < 64; ++i) Lr[i] = Lp_[i * 64 + lane]; } while (0)
#define P2_VCONV(hv_, be_, first_, step_) do { for (int it_ = (first_); it_ < 512; it_ += (step_)) { \
            const int c = it_ & 127, q4 = it_ >> 7, col = 4096 + (hv_) * 128 + c; \
            const float w0 = cw[col], w1 = cw[8192 + col], w2 = cw[2 * 8192 + col], w3 = cw[3 * 8192 + col]; \
            const int ts = t0 + 16 * q4; u16 xr[19]; \
            _Pragma("unroll") for (int t = 0; t < 19; ++t) { const int tt = ts - 3 + t; xr[t] = PQ[(size_t)(tt < 0 ? 0 : tt) * 8192 + col]; } \
            float x0 = ts >= 3 ? bf2f(xr[0]) : 0.f, x1 = ts >= 3 ? bf2f(xr[1]) : 0.f, x2 = ts >= 3 ? bf2f(xr[2]) : 0.f; \
            _Pragma("unroll") for (int t = 0; t < 16; ++t) { const float x3 = bf2f(xr[t + 3]); const float y = w0 * x0 + w1 * x1 + w2 * x2 + w3 * x3; const int tok = 16 * q4 + t; \
                VbT[c * 72 + tok] = f2bf((be_)[tok] * silu_f(y)); x0 = x1; x1 = x2; x2 = x3; } } } while (0)
#define P2_KBE(be_, g_, first_, step_) do { for (int i = (first_); i < 128 * 64; i += (step_)) { const int d = i >> 6, tok = i & 63; KbeT[d * 72 + tok] = f2bf(bf2f(Kb[tok * 136 + d]) * (be_)[tok] * __expf((g_)[tok])); } } while (0)
#define P2_TILES(Tp_, ob_) do { \
            { const int mt = wave >> 2, nt = wave & 3; v16f c = {}; c = mm_tile(c, (Tp_) + 32 * mt * 72, 72, VbT + 32 * nt * 72, 72, 64, lane); \
              v8s lo = pack8f(c[0], c[1], c[2], c[3], c[4], c[5], c[6], c[7]), hi8 = pack8f(c[8], c[9], c[10], c[11], c[12], c[13], c[14], c[15]); \
              unsigned char* d = (ob_) + OP_U + nt * 4096 + (mt * 64 + lane) * 32; *(v8s*)d = lo; *(v8s*)(d + 16) = hi8; } \
            { const int t = wave >> 1, mt = wave & 1; v16f c = {}; c = mm_tile(c, KbeT + 32 * t * 72, 72, (Tp_) + 32 * mt * 72, 72, 64, lane); \
              v8s lo = pack8f(-c[0], -c[1], -c[2], -c[3], -c[4], -c[5], -c[6], -c[7]), hi8 = pack8f(-c[8], -c[9], -c[10], -c[11], -c[12], -c[13], -c[14], -c[15]); \
              *(v8s*)((ob_) + OP_W + (mt * 8 + 2 * t) * 1024 + lane * 16) = lo; *(v8s*)((ob_) + OP_W + (mt * 8 + 2 * t + 1) * 1024 + lane * 16) = hi8; } } while (0)
        LAS u16* Tb1 = (LAS u16*)Lf;
        unsigned char* ob0 = OPS + (size_t)((2 * hq) * 128 + ch) * OPS_BLK; unsigned char* ob1 = ob0 + (size_t)128 * OPS_BLK;
        float Lr[64];
        P2_FILL_L(0); __syncthreads();
        if (wave == 0) P2_LOAD_L();
        __syncthreads();
        P2_FILL_L(1); __syncthreads();
        if (wave == 1) P2_LOAD_L();
        __syncthreads();
        if (wave < 2) {
            float tc[64];
            int lane_o = lane; asm volatile("" : "+v"(lane_o));
#pragma unroll
            for (int i = 0; i < 64; ++i) {
                float acc = (lane_o == i) ? 1.f : 0.f;
#pragma unroll
                for (int j = 0; j < i; ++j) acc -= __int_as_float(__builtin_amdgcn_readlane(__float_as_int(Lr[i]), j)) * tc[j];
                tc[i] = acc;
            }
            LAS u16* Tw = wave == 0 ? Tb : Tb1;
#pragma unroll
            for (int i = 0; i < 64; ++i) Tw[i * 72 + lane] = f2bf(tc[i]);
        } else {
            const int t2 = tid - 128;
            for (int hvl = 0; hvl < 2; ++hvl) {
                const LAS float* g = gc + hvl * 64; unsigned char* ob = hvl ? ob1 : ob0;
                for (int task = t2; task < 1024; task += 384) {
                    const int f = task >> 6, l = task & 63, m = l & 31, h2 = l >> 5, mi = f >> 3, ks = f & 7;
                    const int tok = 32 * mi + m, d0 = 16 * ks + 4 * h2; const float eg = __expf(g[tok]);
                    const LAS u16* q = Qb + tok * 136 + d0;
                    *(v8s*)(ob + OP_QD + f * 1024 + l * 16) = pack8f(bf2f(q[0]) * eg, bf2f(q[1]) * eg, bf2f(q[2]) * eg, bf2f(q[3]) * eg, bf2f(q[8]) * eg, bf2f(q[9]) * eg, bf2f(q[10]) * eg, bf2f(q[11]) * eg);
                }
                const float g63 = g[63];
                for (int task = t2; task < 1024; task += 384) {
                    const int f = task >> 6, l = task & 63, m = l & 31, h2 = l >> 5, t = f >> 2, ks = f & 3;
                    const int tk0 = 16 * ks + 4 * h2, d = 32 * t + m; float v[8];
#pragma unroll
                    for (int j = 0; j < 8; ++j) { const int tok = tk0 + (j & 3) + 8 * (j >> 2); v[j] = bf2f(Kb[tok * 136 + d]) * __expf(g63 - g[tok]); }
                    *(v8s*)(ob + OP_KD + f * 1024 + l * 16) = pack8f(v[0], v[1], v[2], v[3], v[4], v[5], v[6], v[7]);
                }
                for (int task = t2; task < 512; task += 384) {
                    const int f = task >> 6, l = task & 63, m = l & 31, h2 = l >> 5, mi = f >> 2, ks = f & 3;
                    const int i = 32 * mi + m, tk0 = 16 * ks + 4 * h2; const float gi = g[i]; float v[8];
#pragma unroll
                    for (int j = 0; j < 8; ++j) { const int tok = tk0 + (j & 3) + 8 * (j >> 2); v[j] = tok <= i ? QKf[i * 65 + tok] * __expf(gi - g[tok]) : 0.f; }
                    *(v8s*)(ob + OP_QK + f * 1024 + l * 16) = pack8f(v[0], v[1], v[2], v[3], v[4], v[5], v[6], v[7]);
                }
            }
            P2_VCONV(2 * hq, beta, t2, 384);
            P2_KBE(beta, gc, t2, 384);
        }
        __syncthreads();
        P2_TILES(Tb, ob0);
        __syncthreads();
        P2_VCONV(2 * hq + 1, beta + 64, tid, 512);
        P2_KBE(beta + 64, gc + 64, tid, 512);
        __syncthreads();
        P2_TILES(Tb1, ob1);
#undef P2_FILL_L
#undef P2_LOAD_L
#undef P2_VCONV
#undef P2_KBE
#undef P2_TILES
      }
    }
}

template <bool HYB, int HV_LIM> __device__ __forceinline__ void phase_gdn_scan(const Params& p, LAS unsigned char* lds) {
    volatile LAS int* fl = (volatile LAS int*)(lds + 2 * SCAN_BUF);
    if (otid() == 0) { fl[0] = 0; fl[1] = 0; }
    __syncthreads();
    if (otid() >= 128 || (blockIdx.x >> 3) >= 16) return;
    const int lane = otid() & 63, role = __builtin_amdgcn_readfirstlane((int)otid() >> 6), hv = (blockIdx.x & 7) * 4 + (blockIdx.x >> 5), nt = (blockIdx.x >> 3) & 3, n = lane & 31, hi = lane >> 5;
    if (hv >= HV_LIM) return;
    const unsigned char* src0 = p.ws + (HYB ? WS_OPS_H : WS_OPS) + (size_t)hv * 128 * OPS_BLK;
    float* og = (float*)(p.ws + WS_OG);
    v16f St[4];
#pragma unroll
    for (int t = 0; t < 4; ++t)
#pragma unroll
        for (int r = 0; r < 16; ++r) St[t][r] = 0.f;
#define SCAN_ISSUE(c_, buf_) do { const unsigned char* s_ = src0 + (size_t)(c_) * OPS_BLK + lane * 16; LAS unsigned char* d_ = lds + (buf_) * SCAN_BUF; \
        _Pragma("unroll") for (int i_ = 0; i_ < 56; ++i_) __builtin_amdgcn_global_load_lds((const unsigned*)(s_ + i_ * 1024), (LAS unsigned*)(d_ + i_ * 1024), 16, 0, 0); \
        _Pragma("unroll") for (int i_ = 0; i_ < 4; ++i_) __builtin_amdgcn_global_load_lds((const unsigned*)(s_ + OP_U + nt * 4096 + i_ * 1024), (LAS unsigned*)(d_ + OP_U + i_ * 1024), 16, 0, 0); } while (0)
    if (role == 1) {
        for (int c = 0; c < 128; ++c) {
            if (c >= 2) { while (fl[1] < c - 1) __builtin_amdgcn_s_sleep(1); }
            asm volatile("" ::: "memory");
            SCAN_ISSUE(c, c & 1);
            VM_WAIT();
            if (lane == 0) fl[0] = c + 1;
        }
        return;
    }
    const int gl_lo = __float_as_int(*(const float*)(src0 + (size_t)lane * OPS_BLK + OP_GL)), gl_hi = __float_as_int(*(const float*)(src0 + (size_t)(lane + 64) * OPS_BLK + OP_GL));
#define SB_() __builtin_amdgcn_sched_barrier(0)
#define FR_(off) (*(const LAS v8s*)(B + (off) + lane * 16))
#define LD_W(f, k0)  do { _Pragma("unroll") for (int q_ = 0; q_ < 8; ++q_) f[q_] = FR_(OP_W + ((q_ & 1) * 8 + (k0) + (q_ >> 1)) * 1024); } while (0)
#define LD_QD(f, k0) do { _Pragma("unroll") for (int q_ = 0; q_ < 8; ++q_) f[q_] = FR_(OP_QD + ((q_ & 1) * 8 + (k0) + (q_ >> 1)) * 1024); } while (0)
#define LD_QK(f)     do { _Pragma("unroll") for (int q_ = 0; q_ < 8; ++q_) f[q_] = FR_(OP_QK + ((q_ & 1) * 4 + (q_ >> 1)) * 1024); } while (0)
#define LD_KD(f, k0) do { _Pragma("unroll") for (int q_ = 0; q_ < 8; ++q_) f[q_] = FR_(OP_KD + ((q_ & 3) * 4 + (k0) + (q_ >> 2)) * 1024); } while (0)
    for (int c = 0; c < 128; ++c) {
        const int buf = c & 1;
        while (fl[0] < c + 1) __builtin_amdgcn_s_sleep(1);
        asm volatile("" ::: "memory");
        const LAS unsigned char* B = lds + buf * SCAN_BUF;
        const float gl = __int_as_float(__builtin_amdgcn_readlane(c < 64 ? gl_lo : gl_hi, c & 63));
        v8s fa[8], fb[8];
        LD_W(fa, 0);
        v8s Sb[8];
#pragma unroll
        for (int t = 0; t < 4; ++t) {
            Sb[2 * t] = pack8f(St[t][0], St[t][1], St[t][2], St[t][3], St[t][4], St[t][5], St[t][6], St[t][7]);
            Sb[2 * t + 1] = pack8f(St[t][8], St[t][9], St[t][10], St[t][11], St[t][12], St[t][13], St[t][14], St[t][15]);
#pragma unroll
            for (int r = 0; r < 16; ++r) St[t][r] *= gl;
        }
        v16f Vn[2], O2[2];
#pragma unroll
        for (int mt = 0; mt < 2; ++mt) {
            const v4u u0 = *(const LAS v4u*)(B + OP_U + (mt * 64 + lane) * 32), u1 = *(const LAS v4u*)(B + OP_U + (mt * 64 + lane) * 32 + 16);
            Vn[mt][0] = bflo(u0.x); Vn[mt][1] = bfhi(u0.x); Vn[mt][2] = bflo(u0.y); Vn[mt][3] = bfhi(u0.y); Vn[mt][4] = bflo(u0.z); Vn[mt][5] = bfhi(u0.z); Vn[mt][6] = bflo(u0.w); Vn[mt][7] = bfhi(u0.w);
            Vn[mt][8] = bflo(u1.x); Vn[mt][9] = bfhi(u1.x); Vn[mt][10] = bflo(u1.y); Vn[mt][11] = bfhi(u1.y); Vn[mt][12] = bflo(u1.z); Vn[mt][13] = bfhi(u1.z); Vn[mt][14] = bflo(u1.w); Vn[mt][15] = bfhi(u1.w);
#pragma unroll
            for (int r = 0; r < 16; ++r) O2[mt][r] = 0.f;
        }
        SB_(); LD_W(fb, 4); SB_();
#pragma unroll
        for (int q = 0; q < 8; ++q) Vn[q & 1] = __builtin_amdgcn_mfma_f32_32x32x16_bf16(fa[q], Sb[q >> 1], Vn[q & 1], 0, 0, 0);
        SB_(); LD_QD(fa, 0); SB_();
#pragma unroll
        for (int q = 0; q < 8; ++q) Vn[q & 1] = __builtin_amdgcn_mfma_f32_32x32x16_bf16(fb[q], Sb[4 + (q >> 1)], Vn[q & 1], 0, 0, 0);
        SB_(); LD_QD(fb, 4); SB_();
#pragma unroll
        for (int q = 0; q < 8; ++q) O2[q & 1] = __builtin_amdgcn_mfma_f32_32x32x16_bf16(fa[q], Sb[q >> 1], O2[q & 1], 0, 0, 0);
        SB_(); LD_QK(fa); SB_();
#pragma unroll
        for (int q = 0; q < 8; ++q) O2[q & 1] = __builtin_amdgcn_mfma_f32_32x32x16_bf16(fb[q], Sb[4 + (q >> 1)], O2[q & 1], 0, 0, 0);
        v8s Vb[4];
#pragma unroll
        for (int mt = 0; mt < 2; ++mt) {
            Vb[2 * mt] = pack8f(Vn[mt][0], Vn[mt][1], Vn[mt][2], Vn[mt][3], Vn[mt][4], Vn[mt][5], Vn[mt][6], Vn[mt][7]);
            Vb[2 * mt + 1] = pack8f(Vn[mt][8], Vn[mt][9], Vn[mt][10], Vn[mt][11], Vn[mt][12], Vn[mt][13], Vn[mt][14], Vn[mt][15]);
        }
        SB_(); LD_KD(fb, 0); SB_();
#pragma unroll
        for (int q = 0; q < 8; ++q) O2[q & 1] = __builtin_amdgcn_mfma_f32_32x32x16_bf16(fa[q], Vb[q >> 1], O2[q & 1], 0, 0, 0);
        SB_(); LD_KD(fa, 2); SB_();
#pragma unroll
        for (int q = 0; q < 8; ++q) St[q & 3] = __builtin_amdgcn_mfma_f32_32x32x16_bf16(fb[q], Vb[q >> 2], St[q & 3], 0, 0, 0);
        SB_();
#pragma unroll
        for (int q = 0; q < 8; ++q) St[q & 3] = __builtin_amdgcn_mfma_f32_32x32x16_bf16(fa[q], Vb[2 + (q >> 2)], St[q & 3], 0, 0, 0);
        LDS_WAIT(); if (lane == 0) fl[1] = c + 1;
#pragma unroll
        for (int mi = 0; mi < 2; ++mi)
#pragma unroll
            for (int r = 0; r < 16; ++r) og[(size_t)(c * 64 + 32 * mi + crow(r, hi)) * GV + hv * 128 + nt * 32 + n] = O2[mi][r];
    }
#undef SB_
#undef FR_
#undef LD_W
#undef LD_QD
#undef LD_QK
#undef LD_KD
#undef SCAN_ISSUE
}

__device__ __forceinline__ float conv4_at(const u16* PQ, const float* cw, int t, int col) {
    float y = 0.f;
#pragma unroll
    for (int j = 0; j < 4; ++j) { const int tt = t - 3 + j; const float w = tt >= 0 ? cw[j * 8192 + col] : 0.f; y += w * bf2f(PQ[(size_t)(tt < 0 ? 0 : tt) * 8192 + col]); }
    return silu_f(y);
}
__device__ __forceinline__ void phase_gdn_prep_simple(const Params& p) {
    const int tid = otid(), lane = tid & 63, wave = tid >> 6;
    const int gw = blockIdx.x * 8 + wave, NGW = gridDim.x * 8;
    const u16* PQ = (const u16*)(p.ws + WS_PQKV); const float* BA = (const float*)(p.ws + WS_BA); const float* cw = p.in[13];
    float* SQ = (float*)(p.ws + WS_SQ); float* SK = (float*)(p.ws + WS_SK); float* SV = (float*)(p.ws + WS_SV); float* SG = (float*)(p.ws + WS_SG);
    for (int it = gw; it < S_ * 16; it += NGW) {
        const int t = it >> 4, hq = it & 15;
        const int c0 = 2 * lane;
        const float q0 = conv4_at(PQ, cw, t, hq * 128 + c0), q1 = conv4_at(PQ, cw, t, hq * 128 + c0 + 1);
        const float k0 = conv4_at(PQ, cw, t, 2048 + hq * 128 + c0), k1 = conv4_at(PQ, cw, t, 2048 + hq * 128 + c0 + 1);
        const float rq = __builtin_amdgcn_rsqf(wave_sum(q0 * q0 + q1 * q1) + EPS) * 0.08838834764831845f;
        const float rk = __builtin_amdgcn_rsqf(wave_sum(k0 * k0 + k1 * k1) + EPS);
        SQ[(size_t)t * 2048 + hq * 128 + c0] = q0 * rq; SQ[(size_t)t * 2048 + hq * 128 + c0 + 1] = q1 * rq;
        SK[(size_t)t * 2048 + hq * 128 + c0] = k0 * rk; SK[(size_t)t * 2048 + hq * 128 + c0 + 1] = k1 * rk;
#pragma unroll
        for (int hvl = 0; hvl < 2; ++hvl) {
            const int hv = 2 * hq + hvl;
            const float be = 1.f / (1.f + __expf(-BA[(size_t)t * 64 + hv]));
            const float v0 = conv4_at(PQ, cw, t, 4096 + hv * 128 + c0), v1 = conv4_at(PQ, cw, t, 4096 + hv * 128 + c0 + 1);
            SV[(size_t)t * 4096 + hv * 128 + c0] = be * v0; SV[(size_t)t * 4096 + hv * 128 + c0 + 1] = be * v1;
            if (lane == 0) {
                const float xs = BA[(size_t)t * 64 + 32 + hv] + p.in[15][hv];
                const float sp = xs > 20.f ? xs : log1pf(__expf(xs));
                SG[((size_t)t * 32 + hv) * 2] = -__expf(p.in[14][hv]) * sp; SG[((size_t)t * 32 + hv) * 2 + 1] = be;
            }
        }
    }
}
__device__ __forceinline__ void phase_gdn_scan_simple(const Params& p, LAS unsigned char* lds) {
    const int tid = otid(), xcd = blockIdx.x & 7, slot = blockIdx.x >> 3;
    if (slot >= 32) return;
    const int hv = xcd * 4 + (slot >> 3), hq = hv >> 1, cb = 16 * (slot & 7);
    const float* SQ = (const float*)(p.ws + WS_SQ); const float* SK = (const float*)(p.ws + WS_SK); const float* SV = (const float*)(p.ws + WS_SV); const float* SG = (const float*)(p.ws + WS_SG);
    float* og = (float*)(p.ws + WS_OG);
    LAS float* kq = (LAS float*)lds;
    LAS float* gb = kq + 64 * 256;
    LAS float* vb = gb + 128;
    LAS float* ob = vb + 64 * 16;
    float St[8];
#pragma unroll
    for (int d = 0; d < 8; ++d) St[d] = 0.f;
    const int el = (tid >> 4) & 15, h = tid & 15;
    v4f rk[4], rq[4], rv; float rg = 0.f;
#define SS_LOAD(c_) do { \
        _Pragma("unroll") for (int k_ = 0; k_ < 4; ++k_) { const int i_ = tid + 512 * k_, tok_ = i_ >> 5, d4_ = i_ & 31; const size_t g_ = (size_t)((c_) * 64 + tok_) * 2048 + hq * 128 + 4 * d4_; rk[k_] = *(const v4f*)(SK + g_); rq[k_] = *(const v4f*)(SQ + g_); } \
        if (tid < 256) rv = *(const v4f*)(SV + (size_t)((c_) * 64 + (tid >> 2)) * 4096 + hv * 128 + cb + 4 * (tid & 3)); \
        if (tid < 128) rg = SG[((size_t)((c_) * 64 + (tid >> 1)) * 32 + hv) * 2 + (tid & 1)]; } while (0)
    SS_LOAD(0);
    for (int c = 0; c < 128; ++c) {
        __syncthreads();
#pragma unroll
        for (int k = 0; k < 4; ++k) { const int i = tid + 512 * k, tok = i >> 5, d4 = i & 31; *(LAS v4f*)(kq + tok * 256 + 4 * d4) = rk[k]; *(LAS v4f*)(kq + tok * 256 + 128 + 4 * d4) = rq[k]; }
        if (tid < 256) *(LAS v4f*)(vb + 4 * tid) = rv;
        if (tid < 128) { const float ex = __expf(__shfl(rg, (tid & 62), 64)); gb[tid] = (tid & 1) ? rg * ex : ex; }
        __syncthreads();
        if (c + 1 < 128) SS_LOAD(c + 1);
        if (tid < 256) {
            for (int tok0 = 0; tok0 < 64; tok0 += 8) {
                float o8[8];
#pragma unroll
                for (int u = 0; u < 8; ++u) {
                    const int tok = tok0 + u;
                    const float dec = gb[2 * tok], bd = gb[2 * tok + 1];
                    const float bv = vb[tok * 16 + el];
                    const LAS float* kk = kq + tok * 256 + 8 * h; const LAS float* qq = kk + 128;
                    float ks0 = 0.f, ks1 = 0.f;
#pragma unroll
                    for (int d = 0; d < 8; d += 2) { ks0 += kk[d] * St[d]; ks1 += kk[d + 1] * St[d + 1]; }
                    float ks = ks0 + ks1;
                    ks += dpp_f<0xB1>(ks); ks += dpp_f<0x4E>(ks); ks += dpp_f<0x141>(ks); ks += dpp_f<0x140>(ks);
                    const float delta = bv - bd * ks;
                    float o0 = 0.f, o1 = 0.f;
#pragma unroll
                    for (int d = 0; d < 8; d += 2) {
                        St[d] = dec * St[d] + kk[d] * delta; o0 += qq[d] * St[d];
                        St[d + 1] = dec * St[d + 1] + kk[d + 1] * delta; o1 += qq[d + 1] * St[d + 1]; }
                    float o = o0 + o1;
                    o += dpp_f<0xB1>(o); o += dpp_f<0x4E>(o); o += dpp_f<0x141>(o); o += dpp_f<0x140>(o);
                    o8[u] = o;
                }
                if (h == 0) {
#pragma unroll
                    for (int u = 0; u < 8; ++u) ob[(tok0 + u) * 16 + el] = o8[u];
                }
            }
        }
        __syncthreads();
        if (tid < 256) *(v4f*)(og + (size_t)(c * 64 + (tid >> 2)) * GV + hv * 128 + cb + 4 * (tid & 3)) = *(const LAS v4f*)(ob + 4 * tid);
    }
#undef SS_LOAD
}

__device__ __forceinline__ void frag_pos(int row, int kk, int& lane, int& j) {
    const int h2 = (kk >> 2) & 1; j = (kk & 3) + 4 * (kk >> 3); lane = row + 32 * h2; }
template <int HQ_LIM> __device__ __forceinline__ void phase_gdn_check(const Params& p, LAS unsigned char* lds) {
    const int tid = otid();
    const float* SQ = (const float*)(p.ws + WS_SQ); const float* SK = (const float*)(p.ws + WS_SK); const float* SV = (const float*)(p.ws + WS_SV); const float* SG = (const float*)(p.ws + WS_SG);
    const unsigned char* OPS = p.ws + WS_OPS_H; unsigned* flags = (unsigned*)(p.ws + WS_MISC);
    LAS float* Kf = (LAS float*)lds; LAS float* Qf = Kf + 64 * 129; LAS float* Vf = Qf + 64 * 129; LAS float* Tf = Vf + 64 * 129; LAS float* Lx = Tf + 64 * 65; LAS float* gcs = Lx + 64 * 65; LAS float* bes = gcs + 64;
    for (int item = blockIdx.x; item < 2 * HQ_LIM * 128; item += gridDim.x) {
        const int hv = item >> 7, ch = item & 127, hq = hv >> 1, t0 = ch * 64;
        __syncthreads();
        for (int i = tid; i < 64 * 128; i += 512) { const int tok = i >> 7, c = i & 127;
            Kf[tok * 129 + c] = bf2f(f2bf(SK[(size_t)(t0 + tok) * 2048 + hq * 128 + c])); Qf[tok * 129 + c] = bf2f(f2bf(SQ[(size_t)(t0 + tok) * 2048 + hq * 128 + c]));
            Vf[tok * 129 + c] = bf2f(f2bf(SV[(size_t)(t0 + tok) * 4096 + hv * 128 + c])); }
        if (tid == 0) { float a = 0.f; for (int t = 0; t < 64; ++t) { a += SG[((size_t)(t0 + t) * 32 + hv) * 2]; gcs[t] = a; bes[t] = SG[((size_t)(t0 + t) * 32 + hv) * 2 + 1]; } }
        __syncthreads();
        for (int e = tid; e < 4096; e += 512) { const int i = e >> 6, j = e & 63; float v = 0.f;
            if (j < i) { float d = 0.f; for (int c = 0; c < 128; ++c) d += Kf[i * 129 + c] * Kf[j * 129 + c]; v = bes[i] * d * __expf(gcs[i] - gcs[j]); }
            Lx[i * 65 + j] = v; }
        __syncthreads();
        if (tid < 64) { for (int i = 0; i < 64; ++i) { float acc = (tid == i) ? 1.f : 0.f; for (int j = 0; j < i; ++j) acc -= Lx[i * 65 + j] * Tf[j * 65 + tid]; Tf[i * 65 + tid] = acc; } }
        __syncthreads();
        const unsigned char* ob = OPS + (size_t)(hv * 128 + ch) * OPS_BLK;
        unsigned bad = 0u;
        const int i = tid & 63, e = ((tid >> 6) * 17 + ch * 5 + hv) & 127, tau = e & 63;
#define CHK(bit, got, ex) do { const float g_ = (got), x_ = (ex); if (!(__builtin_fabsf(g_ - x_) <= 0.03f * __builtin_fabsf(x_) + 0.03f)) bad |= (bit); } while (0)
        { float u = 0.f, w = 0.f; for (int j = 0; j < 64; ++j) { const float t = Tf[i * 65 + j]; u += (MK_CHECK == 2 ? (j == i ? 1.f : 0.f) : t) * Vf[j * 129 + e]; w += t * Kf[j * 129 + e] * bes[j] * __expf(gcs[j]); }
          { const int ii = i & 31, hi = (ii >> 2) & 1, r = (ii & 3) + 4 * (ii >> 3), lane = (e & 31) + 32 * hi;
            const float got = bf2f(*(const u16*)(ob + OP_U + (e >> 5) * 4096 + ((i >> 5) * 64 + lane) * 32 + r * 2));
            if (!(__builtin_fabsf(got - u) <= 0.1f * __builtin_fabsf(u) + 0.5f)) bad |= 1u | ((i >> 5) ? 2u : 0u) | (((e >> 5) & 1) ? 4u : 0u) | ((e >> 6) ? 8u : 0u) | (r >= 8 ? 16u : 0u) | (hi ? 32u : 0u); }
          { int lane, j; frag_pos(i & 31, e & 15, lane, j); CHK(0u, bf2f(*(const u16*)(ob + OP_W + ((i >> 5) * 8 + (e >> 4)) * 1024 + lane * 16 + j * 2)), -w);
            CHK(0u, bf2f(*(const u16*)(ob + OP_QD + ((i >> 5) * 8 + (e >> 4)) * 1024 + lane * 16 + j * 2)), Qf[i * 129 + e] * __expf(gcs[i])); } }
        { int lane, j; frag_pos(e & 31, i & 15, lane, j);
          CHK(0u, bf2f(*(const u16*)(ob + OP_KD + ((e >> 5) * 4 + (i >> 4)) * 1024 + lane * 16 + j * 2)), Kf[i * 129 + e] * __expf(gcs[63] - gcs[i])); }
        { int lane, j; frag_pos(i & 31, tau & 15, lane, j); float d = 0.f; for (int c = 0; c < 128; ++c) d += Qf[i * 129 + c] * Kf[tau * 129 + c];
          CHK(0u, bf2f(*(const u16*)(ob + OP_QK + ((i >> 5) * 4 + (tau >> 4)) * 1024 + lane * 16 + j * 2)), tau <= i ? d * __expf(gcs[i] - gcs[tau]) : 0.f); }
        if (tid == 0) CHK(0u, *(const float*)(ob + OP_GL), __expf(gcs[63]));
#undef CHK
        if (bad) atomicOr(flags, bad);
    }
}
__device__ __forceinline__ void phase_gdn_post(const Params& p) {
    const int tid = otid(), lane = tid & 63, wave = tid >> 6;
    const int gw = blockIdx.x * 8 + wave, NGW = gridDim.x * 8;
    const float* og = (const float*)(p.ws + WS_OG); const u16* Z = (const u16*)(p.ws + WS_Z); u16* out = (u16*)(p.ws + WS_OGN);
    const int e0 = 4 * (lane & 31); const v4f gn = *(const v4f*)(p.in[16] + e0);
    for (int it0 = gw * 4; it0 < S_ * 16; it0 += NGW * 4) {
        v4f ow[4]; v2u zw[4]; float ss[4];
#pragma unroll
        for (int u = 0; u < 4; ++u) { const int it = it0 + u, t = it >> 4, hv = 2 * (it & 15) + (lane >> 5); const size_t off = (size_t)t * GV + hv * 128 + e0;
            ow[u] = *(const v4f*)(og + off); zw[u] = *(const v2u*)(Z + off); }
#pragma unroll
        for (int u = 0; u < 4; ++u) ss[u] = (ow[u][0] * ow[u][0] + ow[u][1] * ow[u][1]) + (ow[u][2] * ow[u][2] + ow[u][3] * ow[u][3]);
#pragma unroll
        for (int o = 1; o < 32; o <<= 1) {
#pragma unroll
            for (int u = 0; u < 4; ++u) ss[u] += __shfl_xor(ss[u], o); }
#pragma unroll
        for (int u = 0; u < 4; ++u) { const int it = it0 + u, t = it >> 4, hv = 2 * (it & 15) + (lane >> 5); const size_t off = (size_t)t * GV + hv * 128 + e0;
            const float rs = __builtin_amdgcn_rsqf(ss[u] * (1.f / 128.f) + EPS);
            v2u w; w.x = cvtpk(ow[u][0] * rs * gn[0] * silu_f(bflo(zw[u].x)), ow[u][1] * rs * gn[1] * silu_f(bfhi(zw[u].x)));
            w.y = cvtpk(ow[u][2] * rs * gn[2] * silu_f(bflo(zw[u].y)), ow[u][3] * rs * gn[3] * silu_f(bfhi(zw[u].y)));
            *(v2u*)(out + off) = w; }
    }
}

#define XB_TMO      128
#define XB_XCNT(j)  (256  + 64 * (j))
#define XB_XSUB(j)  (1280 + 64 * (j))
#define XB_XGEN(j)  (2304 + 64 * (j))
#define XB_TOP      3328
#define XB_TOPGEN   3392
#define XCD_BAR_WORDS 3456
#define XB_SPIN_CAP (1u << 18)

__device__ __forceinline__ unsigned xb_ld(unsigned* p)              { return __hip_atomic_load(p, __ATOMIC_RELAXED, __HIP_MEMORY_SCOPE_AGENT); }
__device__ __forceinline__ unsigned xb_add(unsigned* p, unsigned v) { return __hip_atomic_fetch_add(p, v, __ATOMIC_RELAXED, __HIP_MEMORY_SCOPE_AGENT); }
__device__ __forceinline__ unsigned xb_xcc_id() { return (unsigned)__builtin_amdgcn_s_getreg((3 << 11) | 20) & 0xFu; }
#define XB_SPIN(cond, bar) do { unsigned _sp = 0; while (cond) { __builtin_amdgcn_s_sleep(1); \
    if ((++_sp & 255u) == 0u) { if (xb_ld(&(bar)[XB_TMO])) break; if (_sp > XB_SPIN_CAP) { atomicAdd(&(bar)[XB_TMO], 1u); break; } } } } while (0)

struct XcdBarrier {
    unsigned* bar; unsigned x;
    volatile LAS unsigned* st;
};

__device__ __forceinline__ XcdBarrier xcd_barrier_post(unsigned* bar, volatile LAS unsigned* st) {
    XcdBarrier b; b.bar = bar; b.x = xb_xcc_id(); b.st = st;
    if (otid() == 0) (void)xb_add(&bar[XB_XCNT(b.x)], 1u);
    return b;
}
__device__ __forceinline__ void xcd_barrier_complete(unsigned* bar, unsigned x, unsigned& nloc, unsigned& nx) {
    const unsigned G = gridDim.x * gridDim.y * gridDim.z;
    unsigned sum, cnt, mine, sp = 0u;
    for (;;) {
        sum = 0u; cnt = 0u; mine = 0u;
#pragma unroll
        for (unsigned j = 0; j < 16; ++j) { const unsigned c = xb_ld(&bar[XB_XCNT(j)]); sum += c; cnt += (c > 0u) ? 1u : 0u; mine = (j == x) ? c : mine; }
        if (sum == G) break;
        __builtin_amdgcn_s_sleep(1);
        if ((++sp & 255u) == 0u) { if (xb_ld(&bar[XB_TMO])) break; if (sp > XB_SPIN_CAP) { atomicAdd(&bar[XB_TMO], 1u); break; } }
    }
    nloc = mine > 0u ? mine : 1u; nx = cnt > 0u ? cnt : 1u;
}

__device__ __forceinline__ void xcd_barrier(const XcdBarrier& b) {
    asm volatile("s_waitcnt vmcnt(0)" ::: "memory");
    __syncthreads();
    if (otid() == 0) {
        unsigned* bar = b.bar;
        __builtin_amdgcn_s_waitcnt(0);
        unsigned nloc = b.st[0], nx = b.st[1];
        if (nloc == 0u) { xcd_barrier_complete(bar, b.x, nloc, nx); b.st[0] = nloc; b.st[1] = nx; }
        const unsigned old = xb_add(&bar[XB_XSUB(b.x)], 1u);
        const unsigned gen = old / nloc;
        if (old + 1u == (gen + 1u) * nloc) {
            __builtin_amdgcn_fence(__ATOMIC_RELEASE, "agent");
            asm volatile("s_waitcnt vmcnt(0)" ::: "memory");
            const unsigned og = xb_add(&bar[XB_TOP], 1u);
            const unsigned tg = og / nx;
            if (og + 1u == (tg + 1u) * nx) xb_add(&bar[XB_TOPGEN], 1u);
            else XB_SPIN(xb_ld(&bar[XB_TOPGEN]) == tg, bar);
            __builtin_amdgcn_fence(__ATOMIC_ACQUIRE, "agent");
            xb_add(&bar[XB_XGEN(b.x)], 1u);
            asm volatile("s_waitcnt vmcnt(0)" ::: "memory");
        } else {
            XB_SPIN(xb_ld(&bar[XB_XGEN(b.x)]) == gen, bar);
            __builtin_amdgcn_fence(__ATOMIC_ACQUIRE, "agent");
            asm volatile("s_waitcnt vmcnt(0)" ::: "memory");
        }
    }
    __syncthreads();
}

constexpr size_t WS_BAR = WS_MISC + 65536;
constexpr int LDS_BARST = LDS_BYTES - 16;

constexpr int NPHASE = 16;
template <int ph> __device__ __forceinline__ void run_phase(const Params& p, LAS unsigned char* lds, unsigned char* lds_raw) {
    unsigned char* ws = p.ws;
    float* ssq = (float*)(ws + WS_SSQ);
    u16* XB = (u16*)(ws + WS_XB);
    const int G = gridDim.x, c = blockIdx.x;
    switch (ph) {
    case 0: phase_p0(p, lds); break;
    case 1: { pg8::Gemm g{XB, (const u16*)(ws + WS_WQKV), S_, NQKV, DM}; pg8::StaticOrder S; S.init(S_, NQKV, G, c);
              EpiQKV E{(u16*)(ws + WS_QH), p.in[4], (long)(p.in[5] - p.in[4]), (LAS float*)(lds + XCH_OFF)};
              pg8::gemm_phase<EpiQKV, pg8::StaticOrder>(lds, g, S, E, nullptr); } break;
    case 2: phase_attn(p, (char*)lds_raw); break;
    case 3: phase_combine(p); break;
    case 4: { pg8::Gemm g{(const u16*)(ws + WS_OB), (const u16*)(ws + WS_WO), S_, DM, DM}; pg8::StaticOrder S; S.init(S_, DM, G, c);
              EpiRes E{p.in[0], p.out, XB, ssq}; pg8::gemm_phase<EpiRes, pg8::StaticOrder>(lds, g, S, E, nullptr); } break;
    case 5: case 13: { const int l = ph == 13; pg8::Gemm g{XB, (const u16*)(ws + (l ? WS_WUP1 : WS_WUP0)), S_, NUP, DM}; pg8::StaticOrder S; S.init(S_, NUP, G, c);
              EpiScale E{ssq + (l ? 64 * S_ : 0), (u16*)(ws + WS_U), NUP, NUP, nullptr, 0, NUP, nullptr, 0, NUP};
              pg8::gemm_phase<EpiScale, pg8::StaticOrder>(lds, g, S, E, nullptr); } break;
    case 6: case 14: phase_convgate(p, ph == 14); break;
    case 7: case 15: { const int l = ph == 15; pg8::Gemm g{(const u16*)(ws + WS_Y), (const u16*)(ws + (l ? WS_WDN1 : WS_WDN0)), S_, DM, DFF}; pg8::StaticOrder S; S.init(S_, DM, G, c);
              EpiRes E{p.out, p.out, l ? nullptr : XB, l ? nullptr : ssq + 32 * S_}; pg8::gemm_phase<EpiRes, pg8::StaticOrder>(lds, g, S, E, nullptr); } break;
    case 8: { pg8::Gemm g{XB, (const u16*)(ws + WS_WIN), S_, 12288, DM}; pg8::StaticOrder S; S.init(S_, 12288, G, c);
              EpiScale E{ssq + 32 * S_, (u16*)(ws + WS_PQKV), 8192, 8192, (u16*)(ws + WS_Z), GV, 12288, nullptr, 0, 12288};
              pg8::gemm_phase<EpiScale, pg8::StaticOrder>(lds, g, S, E, nullptr);
              phase_ba(p, lds); } break;
#if MK_GDN_SIMPLE
    case 9: phase_gdn_prep_simple(p); break;
    case 10: phase_gdn_scan_simple(p, lds); break;
#else
    case 9: phase_gdn_prep<false, 16>(p, lds); break;
    case 10: if ((blockIdx.x >> 3) >= 16) phase_p0_late(p, lds, (int)blockIdx.x - 128, (int)gridDim.x - 128); else phase_gdn_scan<false, 32>(p, lds); break;
#endif
    case 11: phase_gdn_post(p); break;
    case 12: { pg8::Gemm g{(const u16*)(ws + WS_OGN), (const u16*)(ws + WS_WOUT), S_, DM, GV}; pg8::StaticOrder S; S.init(S_, DM, G, c);
              EpiRes E{p.out, p.out, XB, ssq + 64 * S_}; pg8::gemm_phase<EpiRes, pg8::StaticOrder>(lds, g, S, E, nullptr); } break;
    default: break;
    }
}
#ifdef MK_TEST_PHASES
template <int PH> __global__ void __launch_bounds__(512, 2) t_ph(Params p) {
    extern __shared__ __attribute__((aligned(16))) unsigned char lds_raw[];
    run_phase<PH>(p, (LAS unsigned char*)lds_raw, lds_raw);
}
template __global__ void t_ph<0>(Params); template __global__ void t_ph<1>(Params); template __global__ void t_ph<2>(Params); template __global__ void t_ph<3>(Params);
template __global__ void t_ph<4>(Params); template __global__ void t_ph<5>(Params); template __global__ void t_ph<6>(Params); template __global__ void t_ph<7>(Params);
template __global__ void t_ph<8>(Params); template __global__ void t_ph<9>(Params); template __global__ void t_ph<10>(Params); template __global__ void t_ph<11>(Params);
template __global__ void t_ph<12>(Params);
#endif
__global__ void __launch_bounds__(512, 2) mk_fwd(Params p) {
    extern __shared__ __attribute__((aligned(16))) unsigned char lds_raw[];
    LAS unsigned char* lds = (LAS unsigned char*)lds_raw;
    cg::grid_group grid = cg::this_grid();
    const int lo = p.ph_lo, hi = p.ph_hi;
    if (otid() < 4) ((LAS unsigned*)(lds + LDS_BARST))[otid()] = 0u;
    __syncthreads();
    const XcdBarrier bar = xcd_barrier_post((unsigned*)(p.ws + WS_BAR), (volatile LAS unsigned*)(lds + LDS_BARST));
#define GSYNC() xcd_barrier(bar)
    if (hi > 1000) grid.sync();
#define PHASE(k) if (lo <= (k) && (k) < hi) { if ((MK_DUP_MASK >> (k)) & 1) { run_phase<k>(p, lds, lds_raw); __syncthreads(); } run_phase<k>(p, lds, lds_raw); if ((k) + 1 < hi) GSYNC(); }
    PHASE(0) PHASE(1)
    PHASE(2) PHASE(3) PHASE(4) PHASE(5) PHASE(6) PHASE(7) PHASE(8) PHASE(9) PHASE(10)
#if MK_HYBRID
#if MK_CHECK
    { phase_gdn_prep<true, MK_HYBRID>(p, lds); grid.sync(); phase_gdn_check<MK_HYBRID>(p, lds); grid.sync();
      const float code = 1000.f * (float)(*(const unsigned*)(p.ws + WS_MISC));
      for (size_t i = (size_t)blockIdx.x * 512 + otid(); i < (size_t)S_ * DM; i += (size_t)gridDim.x * 512) p.out[i] = code;
      return; }
#endif
    if (lo <= 10 && 11 < hi) { phase_gdn_prep<true, MK_HYBRID>(p, lds); grid.sync(); phase_gdn_scan<true, 2 * MK_HYBRID>(p, lds); grid.sync(); }
#endif
    PHASE(11) PHASE(12) PHASE(13) PHASE(14) PHASE(15)
#undef PHASE
#ifdef MK_DUMP_OFF
    grid.sync();
    { const u16* src = (const u16*)(p.ws + (size_t)MK_DUMP_OFF); const size_t gt = (size_t)blockIdx.x * 512 + otid(), NT = (size_t)gridDim.x * 512;
      for (size_t i = gt; i < (size_t)S_ * DM; i += NT) {
          const int cat = (int)(i / 3355443), j = (int)(i % 3355443); if (cat > 4) { p.out[i] = 0.f; continue; }
          const int blk = j & 4095, e = (j >> 12) & 4095;
          const int opx = cat == 0 ? OP_QD : cat == 1 ? OP_KD : cat == 2 ? OP_QK : cat == 3 ? OP_W : OP_U;
          const float wgt = cat == 0 ? 1e6f : cat == 1 ? 1e5f : cat == 2 ? 1e4f : cat == 3 ? 1e3f : 1e2f;
          const float v = bf2f(src[(size_t)blk * (OPS_BLK / 2) + opx / 2 + e * 4]);
          p.out[i] = !(__builtin_fabsf(v) < 50.f) ? wgt : 0.f; } }
#endif
}

#ifndef MK_PH_HI
#endif
extern "C" void kernel_launch(void* const* d_in, const int* in_sizes, int n_in, void* d_out, int out_size, void* d_ws, size_t ws_size, hipStream_t stream) {
    static int grid = 0;
    if (grid == 0) {
        if (n_in != 22 || out_size != S_ * DM || ws_size < WS_END) { fprintf(stderr, "kernel_launch: unexpected shapes (n_in %d out %d ws %zu)\n", n_in, out_size, ws_size); grid = -1; return; }
        int dev = 0, cus = 0, per_cu = 0;
        (void)hipGetDevice(&dev); (void)hipDeviceGetAttribute(&cus, hipDeviceAttributeMultiprocessorCount, dev);
        if (hipFuncSetAttribute((const void*)mk_fwd, hipFuncAttributeMaxDynamicSharedMemorySize, LDS_BYTES) != hipSuccess) { fprintf(stderr, "kernel_launch: hipFuncSetAttribute failed\n"); grid = -1; return; }
        if (hipOccupancyMaxActiveBlocksPerMultiprocessor(&per_cu, (const void*)mk_fwd, 512, LDS_BYTES) != hipSuccess || per_cu < 1) { fprintf(stderr, "kernel_launch: occupancy query says %d\n", per_cu); per_cu = 1; }
        (void)hipGetLastError();
        if (cus <= 0) cus = 256;
        grid = cus;
    }
    if (grid < 0) return;
    if (hipMemsetAsync((char*)d_ws + WS_BAR, 0, XCD_BAR_WORDS * 4, stream) != hipSuccess) { fprintf(stderr, "kernel_launch: memset of the barrier words failed\n"); return; }
    Params p{};
    for (int i = 0; i < 22; ++i) p.in[i] = (const float*)d_in[i];
    p.out = (float*)d_out; p.ws = (unsigned char*)d_ws;
#if MK_PER_PHASE
    for (int ph = 0; ph < NPHASE; ++ph) { p.ph_lo = ph; p.ph_hi = ph + 1; void* args[] = {&p};
        hipError_t e = hipLaunchCooperativeKernel((const void*)mk_fwd, dim3(grid), dim3(512), args, LDS_BYTES, stream);
        if (e != hipSuccess) { fprintf(stderr, "launch %d failed: %s\n", ph, hipGetErrorString(e)); break; } }
#else
    p.ph_lo = 0; p.ph_hi = MK_PH_HI; void* args[] = {&p};
    hipError_t e = hipLaunchCooperativeKernel((const void*)mk_fwd, dim3(grid), dim3(512), args, LDS_BYTES, stream);
    if (e != hipSuccess) fprintf(stderr, "cooperative launch failed: %s (grid %d)\n", hipGetErrorString(e), grid);
#endif
}
```
